# Optimizing an MI355X kernel written in HIP

```python
import jax, jax.numpy as jnp
from jax import lax
import numpy as np

D_MODEL = 1024
BATCH = 8
SEQ = 2048
DEPTH = 4
DEC_BATCH = 128
DEC_SEQ = 4
PAST_LEN = 8192
PAGE_SIZE = 128

N_HEADS = 8
HEAD_DIM = 64
N_KV_HEADS = 2
GROUP = N_HEADS // N_KV_HEADS
ATTN_W = N_HEADS * HEAD_DIM
KV_W = N_KV_HEADS * HEAD_DIM
CONV_W = D_MODEL - ATTN_W
CONV_K = 3
WINDOW = 128
BLOCK = 128
W_BUF = min(WINDOW, PAST_LEN)
ROPE_THETA = 10000.0
PLE_DIM = 256
EPS = 1e-6
SCALE = HEAD_DIM ** -0.5
NEG = -1e30
IN_W = 2 * ATTN_W + 2 * KV_W + 4 * CONV_W
SPLITS = (ATTN_W, ATTN_W + KV_W, ATTN_W + 2 * KV_W, 2 * ATTN_W + 2 * KV_W,
          2 * ATTN_W + 2 * KV_W + CONV_W, 2 * ATTN_W + 2 * KV_W + 2 * CONV_W,
          2 * ATTN_W + 2 * KV_W + 3 * CONV_W)

kernel_name = "hymba_swa_sink_shortconv_ple_step"


def rmsnorm(x, g):
    xf = x.astype(jnp.float32)
    r = lax.rsqrt(jnp.mean(xf * xf, axis=-1, keepdims=True) + EPS)
    return (xf * r).astype(x.dtype) * g


def rope(x, pos):
    inv = ROPE_THETA ** (-jnp.arange(0, HEAD_DIM, 2, dtype=jnp.float32) / HEAD_DIM)
    ang = pos[:, None] * inv[None, :]
    cos = jnp.concatenate([jnp.cos(ang), jnp.cos(ang)], -1)[None, :, None, :].astype(x.dtype)
    sin = jnp.concatenate([jnp.sin(ang), jnp.sin(ang)], -1)[None, :, None, :].astype(x.dtype)
    x1, x2 = jnp.split(x, 2, axis=-1)
    return x * cos + jnp.concatenate([-x2, x1], -1) * sin


def sink_softmax(s, sink):
    m = jnp.maximum(jnp.max(s, axis=-1, keepdims=True), sink)
    e = jnp.exp(s - m)
    return e / (jnp.sum(e, axis=-1, keepdims=True) + jnp.exp(sink - m))


def branch_inputs(x, g_norm, w_in, pos):
    b, t = x.shape[0], x.shape[1]
    z = rmsnorm(x, g_norm) @ w_in
    q, k, v, ga, bg, cg, hc, gc = jnp.split(z, SPLITS, axis=-1)
    q = rope(q.reshape(b, t, N_HEADS, HEAD_DIM), pos)
    k = rope(k.reshape(b, t, N_KV_HEADS, HEAD_DIM), pos)
    v = v.reshape(b, t, N_KV_HEADS, HEAD_DIM)
    return q, k, v, ga, bg, cg * hc, gc


def attn_prompt(q, k, v, sink):
    b, s_len = q.shape[0], q.shape[1]
    nb = s_len // BLOCK
    qb = q.reshape(b, nb, BLOCK, N_KV_HEADS, GROUP, HEAD_DIM)

    def with_prev(t):
        tb = t.reshape(b, nb, BLOCK, N_KV_HEADS, HEAD_DIM)
        prev = jnp.pad(tb[:, :-1], ((0, 0), (1, 0), (0, 0), (0, 0), (0, 0)))
        return jnp.concatenate([prev, tb], axis=2)

    kk, vv = with_prev(k), with_prev(v)
    s = jnp.einsum('bnqhgd,bnkhd->bnhgqk', qb, kk, preferred_element_type=jnp.float32) * SCALE
    qi = jnp.arange(BLOCK)[:, None]
    kj = jnp.arange(2 * BLOCK)[None, :]
    diff = BLOCK + qi - kj
    blk = jnp.arange(nb)[:, None, None]
    valid = (diff >= 0) & (diff < WINDOW) & (blk * BLOCK - BLOCK + kj >= 0)
    s = jnp.where(valid[None, :, None, None], s, NEG)
    p = sink_softmax(s, sink.astype(jnp.float32).reshape(1, 1, N_KV_HEADS, GROUP, 1, 1))
    o = jnp.einsum('bnhgqk,bnkhd->bnqhgd', p.astype(vv.dtype), vv)
    return o.reshape(b, s_len, ATTN_W)


def attn_sample(q, k, v, kbuf, vbuf, sink):
    b, t = q.shape[0], q.shape[1]
    kk = jnp.concatenate([kbuf, k], axis=1)
    vv = jnp.concatenate([vbuf, v], axis=1)
    qpos = PAST_LEN + jnp.arange(t)
    kpos = jnp.concatenate([PAST_LEN - W_BUF + jnp.arange(W_BUF), qpos])
    diff = qpos[:, None] - kpos[None, :]
    valid = (diff >= 0) & (diff < WINDOW)
    qg = q.reshape(b, t, N_KV_HEADS, GROUP, HEAD_DIM)
    s = jnp.einsum('bqhgd,bkhd->bhgqk', qg, kk, preferred_element_type=jnp.float32) * SCALE
    s = jnp.where(valid[None, None, None], s, NEG)
    p = sink_softmax(s, sink.astype(jnp.float32).reshape(1, N_KV_HEADS, GROUP, 1, 1))
    o = jnp.einsum('bhgqk,bkhd->bqhgd', p.astype(vv.dtype), vv)
    return o.reshape(b, t, ATTN_W), kk[:, -W_BUF:], vv[:, -W_BUF:]


def causal_conv(u_pad, w, t):
    y = w[0] * u_pad[:, 0:t]
    for j in range(1, CONV_K):
        y = y + w[j] * u_pad[:, j:j + t]
    return y


def branch_output(x, o_attn, ga, bg, conv_out, gc, w_out, p_i, w_pg, w_pp):
    mix = jnp.concatenate([o_attn * jax.nn.silu(ga), bg * conv_out * jax.nn.silu(gc)], axis=-1)
    x = x + mix @ w_out
    return x + jax.nn.sigmoid(x @ w_pg) * (p_i @ w_pp)


def setup_inputs(seed: int = 0) -> dict:
    key = jax.random.key(seed)
    ks = jax.random.split(key, 18)
    f32 = jnp.float32
    n = lambda k, s, sc: jax.random.normal(k, s, f32) * sc
    return {
        "x_prompt": n(ks[0], (BATCH, SEQ, D_MODEL), 1.0),
        "x_sample": n(ks[1], (DEC_BATCH, DEC_SEQ, D_MODEL), 1.0),
        "cache_k": n(ks[2], (DEPTH, DEC_BATCH, W_BUF, N_KV_HEADS, HEAD_DIM), 1.0),
        "cache_v": n(ks[3], (DEPTH, DEC_BATCH, W_BUF, N_KV_HEADS, HEAD_DIM), 1.0),
        "state_conv": n(ks[4], (DEPTH, DEC_BATCH, CONV_K - 1, CONV_W), 1.0),
        "p_prompt": n(ks[5], (DEPTH, BATCH, SEQ, PLE_DIM), 1.0),
        "p_sample": n(ks[6], (DEPTH, DEC_BATCH, DEC_SEQ, PLE_DIM), 1.0),
        "g_norm": 1.0 + n(ks[7], (DEPTH, D_MODEL), 0.05),
        "w_in": n(ks[8], (DEPTH, D_MODEL, IN_W), D_MODEL ** -0.5),
        "sinks": n(ks[9], (DEPTH, N_HEADS), 0.5),
        "conv_w": n(ks[10], (DEPTH, CONV_K, CONV_W), CONV_K ** -0.5),
        "w_out": n(ks[11], (DEPTH, D_MODEL, D_MODEL), D_MODEL ** -0.5),
        "w_pg": n(ks[12], (DEPTH, D_MODEL, D_MODEL), D_MODEL ** -0.5),
        "w_pp": n(ks[13], (DEPTH, PLE_DIM, D_MODEL), PLE_DIM ** -0.5),
        "g_final": 1.0 + n(ks[14], (D_MODEL,), 0.05),
    }


def reference(x_prompt, x_sample, cache_k, cache_v, state_conv, p_prompt, p_sample,
              g_norm, w_in, sinks, conv_w, w_out, w_pg, w_pp, g_final):
    pos_p = jnp.arange(SEQ, dtype=jnp.float32)
    pos_s = PAST_LEN + jnp.arange(DEC_SEQ, dtype=jnp.float32)
    xp, xs = x_prompt, x_sample
    nkp, nvp, ncp, nks, nvs, ncs = [], [], [], [], [], []
    for i in range(DEPTH):
        q, k, v, ga, bg, u, gc = branch_inputs(xp, g_norm[i], w_in[i], pos_p)
        oa = attn_prompt(q, k, v, sinks[i])
        u_pad = jnp.pad(u, ((0, 0), (CONV_K - 1, 0), (0, 0)))
        yc = causal_conv(u_pad, conv_w[i], SEQ)
        xp = branch_output(xp, oa, ga, bg, yc, gc, w_out[i], p_prompt[i], w_pg[i], w_pp[i])
        nkp.append(k[:, SEQ - W_BUF:])
        nvp.append(v[:, SEQ - W_BUF:])
        ncp.append(u[:, SEQ - (CONV_K - 1):])
        q, k, v, ga, bg, u, gc = branch_inputs(xs, g_norm[i], w_in[i], pos_s)
        oa, kb, vb = attn_sample(q, k, v, cache_k[i], cache_v[i], sinks[i])
        u_pad = jnp.concatenate([state_conv[i], u], axis=1)
        yc = causal_conv(u_pad, conv_w[i], DEC_SEQ)
        xs = branch_output(xs, oa, ga, bg, yc, gc, w_out[i], p_sample[i], w_pg[i], w_pp[i])
        nks.append(kb)
        nvs.append(vb)
        ncs.append(u_pad[:, -(CONV_K - 1):])
    y_prompt = rmsnorm(xp, g_final)
    y_sample = rmsnorm(xs, g_final)
    return (y_prompt, y_sample, jnp.stack(nkp), jnp.stack(nvp), jnp.stack(ncp),
            jnp.stack(nks), jnp.stack(nvs), jnp.stack(ncs))
```

```cpp
#include <hip/hip_runtime.h>
#include <hip/hip_cooperative_groups.h>
#include <cstdio>
#include <cstdint>
namespace cg = cooperative_groups;
__device__ __forceinline__ int lane_id() { int l; asm volatile("v_mbcnt_lo_u32_b32 %0, -1, 0\n\tv_mbcnt_hi_u32_b32 %0, -1, %0" : "=v"(l)); return l; }
#define TID_OF(w0) ((w0) * 64 + lane_id())
namespace pg8 {
#define PG8_LAS __attribute__((address_space(3)))
typedef unsigned short bf16_t;
typedef short bf16x8 __attribute__((ext_vector_type(8)));
typedef float f32x4 __attribute__((ext_vector_type(4)));
typedef unsigned u32x4 __attribute__((ext_vector_type(4)));
constexpr int BM = 256, BK = 64, HALF = 128, HTB = HALF * BK * 2  , STAGE_BYTES = 8 * HTB, NXCD = 8, WGM = 8;

__host__ __device__ __forceinline__ int lds_byte(int r, int c) { const int st = (r >> 4) * 2 + (c >> 5), rr = r & 15, cc = c & 31, ob = rr * 64 + cc * 2; return st * 1024 + (ob ^ (((ob >> 9) & 1) << 5)); }
__host__ __device__ __forceinline__ void stage_rc(int b, int& R, int& C) { const int st = b / 1024, sb = b % 1024, swz = sb ^ (((sb >> 9) & 1) << 5); R = (st >> 1) * 16 + swz / 64; C = (st & 1) * 32 + (swz % 64) / 2; }
__host__ __device__ __forceinline__ int perm32(int rho) { const int n = rho >> 4, i = rho & 15; return 8 * (i >> 2) + 4 * n + (i & 3); }

struct Unit { int pm, pn; };
struct Gemm { const bf16_t* A; const bf16_t* Bt; int M, N, K; };

struct StaticOrder {
    int nM, nN, nwg, G, c;
    __host__ __device__ void init(int M, int N, int G_, int c_) { nM = M / BM; nN = N / BM; nwg = nM * nN; G = G_; c = c_; }
    __host__ __device__ bool next(int i, Unit& u) const {
        const long L = (long)i * G + c; if (L >= nwg) return false;
        int wgid = (int)L; { const int q = nwg / NXCD, r = nwg % NXCD, xcd = wgid % NXCD, off = wgid / NXCD; wgid = (xcd < r ? xcd * (q + 1) : r * (q + 1) + (xcd - r) * q) + off; }
        const int nig = WGM * nN, gid = wgid / nig, fm = gid * WGM, gsz = (nM - fm) < WGM ? (nM - fm) : WGM;
        u.pm = fm + ((wgid % nig) % gsz); u.pn = (wgid % nig) / gsz; return true;
    }
    __device__ __forceinline__ void a_ready(const Unit&) const {}
    __device__ __forceinline__ void done(const Unit&) const {}
};

__device__ __forceinline__ unsigned cvt_pk_bf16(float lo, float hi) { unsigned r; asm volatile("v_cvt_pk_bf16_f32 %0, %1, %2" : "=v"(r) : "v"(lo), "v"(hi)); return r; }
typedef float f32x2 __attribute__((ext_vector_type(2)));
template <class Epi, class Sched, bool ALIGN_EPI = false, bool SP2 = false>
__device__ __forceinline__ void gemm_phase(PG8_LAS unsigned char* lds, const Gemm g, const Sched& S, const Epi& E, const int w0) {
    int tid_ = TID_OF(w0); asm volatile("" : "+v"(tid_));
    const int tid = tid_, wid = __builtin_amdgcn_readfirstlane(tid >> 6), lane = tid & 63, wr = wid >> 2, wc = wid & 3, fr = lane & 15, fq = lane >> 4;
    const int K = g.K, nt = K / BK;
    unsigned voffA[2], voffB[2];
#pragma unroll
    for (int i = 0; i < 2; ++i) { int R, C; stage_rc(tid * 16 + i * 8192, R, C); const int Rb = Epi::PERM ? ((R & ~31) + perm32(R & 31)) : R;
        voffA[i] = (unsigned)(R * K + C) * 2u; voffB[i] = (unsigned)(Rb * K + C) * 2u; }
    const size_t kstep = (size_t)(BK * 2);
    const size_t hstep = (size_t)HALF * K * 2;
    const size_t tstep = 2 * hstep;
    const unsigned ldsw = (unsigned)wid * 1024u;
    const int aoff = lds_byte(wr * 64 + fr, fq * 8), boff = lds_byte(wc * 32 + fr, fq * 8);
#define PG8_SA(b, h) (((b) * 2 + (h)) * HTB)
#define PG8_SB(b, h) ((4 + (b) * 2 + (h)) * HTB)
#define PG8_STAGE(bufoff, gbase, voff) do { _Pragma("unroll") for (int _i = 0; _i < 2; ++_i) \
        __builtin_amdgcn_global_load_lds((const unsigned*)((const char*)(gbase) + (voff)[_i]), (PG8_LAS unsigned*)(lds + (bufoff) + ldsw + _i * 8192), 16, 0, 0); } while (0)
#define PG8_LDA(dst, b, h) do { _Pragma("unroll") for (int m = 0; m < 4; ++m) _Pragma("unroll") for (int k = 0; k < 2; ++k) dst[m][k] = *(const PG8_LAS bf16x8*)(lds + PG8_SA(b, h) + aoff + m * 2048 + k * 1024); } while (0)
#define PG8_LDB(dst, b, h) do { _Pragma("unroll") for (int n = 0; n < 2; ++n) _Pragma("unroll") for (int k = 0; k < 2; ++k) dst[n][k] = *(const PG8_LAS bf16x8*)(lds + PG8_SB(b, h) + boff + n * 2048 + k * 1024); } while (0)
#define PG8_MMA(ai, bj, At, Bt) do { __builtin_amdgcn_s_setprio(1); _Pragma("unroll") for (int m = 0; m < 4; ++m) _Pragma("unroll") for (int n = 0; n < 2; ++n) _Pragma("unroll") for (int k = 0; k < 2; ++k) \
        acc[ai][bj][m][n] = __builtin_amdgcn_mfma_f32_16x16x32_bf16(Bt[n][k], At[m][k], acc[ai][bj][m][n], 0, 0, 0); __builtin_amdgcn_s_setprio(0); } while (0)
#define PG8_WAIT_V(n) asm volatile("s_waitcnt vmcnt(" #n ")" ::: "memory")
#define PG8_WAIT_L(n) asm volatile("s_waitcnt lgkmcnt(" #n ")" ::: "memory")
#define PG8_BAR __builtin_amdgcn_s_barrier()
#define PG8_SCHED __builtin_amdgcn_sched_barrier(0)
    Unit cur, nxt; int ui = 0;
    if (!S.next(0, cur)) return;
    f32x4 acc[2][2][4][2];
#pragma unroll
    for (int a = 0; a < 2; ++a)
#pragma unroll
        for (int b = 0; b < 2; ++b)
#pragma unroll
            for (int m = 0; m < 4; ++m)
#pragma unroll
                for (int n = 0; n < 2; ++n) acc[a][b][m][n] = (f32x4){0.f, 0.f, 0.f, 0.f};
    bf16x8 At[4][2], B0[2][2], B1[2][2];
    const char* cA = (const char*)g.A + (size_t)cur.pm * tstep; const char* cB = (const char*)g.Bt + (size_t)cur.pn * tstep;
    S.a_ready(cur);
    if constexpr (SP2) {
        PG8_STAGE(PG8_SB(0, 0), cB, voffB); PG8_STAGE(PG8_SB(0, 1), cB + hstep, voffB); PG8_STAGE(PG8_SA(0, 0), cA, voffA); PG8_STAGE(PG8_SA(0, 1), cA + hstep, voffA);
        if (wr == 1) PG8_BAR;
        PG8_WAIT_V(2); PG8_BAR;
        PG8_STAGE(PG8_SB(1, 0), cB + kstep, voffB); PG8_STAGE(PG8_SA(1, 0), cA + kstep, voffA); PG8_STAGE(PG8_SB(1, 1), cB + hstep + kstep, voffB);
        PG8_WAIT_V(6); PG8_BAR;
    } else {
        PG8_STAGE(PG8_SB(0, 0), cB, voffB); PG8_STAGE(PG8_SA(0, 0), cA, voffA); PG8_STAGE(PG8_SB(0, 1), cB + hstep, voffB); PG8_STAGE(PG8_SA(0, 1), cA + hstep, voffA);
        if (wr == 1) PG8_BAR;
        PG8_WAIT_V(4); PG8_BAR;
        PG8_STAGE(PG8_SB(1, 0), cB + kstep, voffB); PG8_STAGE(PG8_SA(1, 0), cA + kstep, voffA); PG8_STAGE(PG8_SB(1, 1), cB + hstep + kstep, voffB);
        PG8_WAIT_V(6); PG8_BAR;
    }
    for (;;) {
        const bool has_next = S.next(ui + 1, nxt);
        const char* nA = has_next ? (const char*)g.A + (size_t)nxt.pm * tstep : cA; const char* nB = has_next ? (const char*)g.Bt + (size_t)nxt.pn * tstep : cB;
#pragma unroll 1
        for (int t = 0; t < nt; t += 2) {
            const bool last = (t == nt - 2);
            const char* a1 = cA + (size_t)(t + 1) * kstep;
            const char* a2 = last ? nA : cA + (size_t)(t + 2) * kstep; const char* b2 = last ? nB : cB + (size_t)(t + 2) * kstep;
            const char* a3 = a2 + kstep; const char* b3 = b2 + kstep;
            if (last && has_next) S.a_ready(nxt);
            if constexpr (SP2) {
            PG8_LDB(B0, 0, 0); PG8_LDB(B1, 0, 1); PG8_SCHED; PG8_LDA(At, 0, 0); PG8_STAGE(PG8_SA(1, 1), a1 + hstep, voffA);
            PG8_WAIT_V(8); PG8_WAIT_L(0); PG8_BAR; PG8_MMA(0, 0, At, B0); PG8_MMA(0, 1, At, B1); PG8_BAR; PG8_SCHED;
            PG8_LDA(At, 0, 1); PG8_STAGE(PG8_SB(0, 0), b2, voffB); PG8_STAGE(PG8_SB(0, 1), b2 + hstep, voffB); PG8_STAGE(PG8_SA(0, 0), a2, voffA);
            PG8_WAIT_V(8); PG8_WAIT_L(0); PG8_BAR; PG8_MMA(1, 0, At, B0); PG8_MMA(1, 1, At, B1); PG8_BAR; PG8_SCHED;
            PG8_LDB(B0, 1, 0); PG8_LDB(B1, 1, 1); PG8_SCHED; PG8_LDA(At, 1, 0); PG8_STAGE(PG8_SA(0, 1), a2 + hstep, voffA);
            PG8_WAIT_V(8); PG8_WAIT_L(0); PG8_BAR; PG8_MMA(0, 0, At, B0); PG8_MMA(0, 1, At, B1); PG8_BAR; PG8_SCHED;
            PG8_LDA(At, 1, 1); PG8_STAGE(PG8_SB(1, 0), b3, voffB); PG8_STAGE(PG8_SB(1, 1), b3 + hstep, voffB); PG8_STAGE(PG8_SA(1, 0), a3, voffA);
            PG8_WAIT_V(8); PG8_WAIT_L(0); PG8_BAR; PG8_MMA(1, 0, At, B0); PG8_MMA(1, 1, At, B1); PG8_BAR; PG8_SCHED;
            } else {
            PG8_LDB(B0, 0, 0); PG8_SCHED; PG8_LDA(At, 0, 0); PG8_STAGE(PG8_SA(1, 1), a1 + hstep, voffA);
            PG8_WAIT_L(8); PG8_BAR; PG8_WAIT_L(0); PG8_MMA(0, 0, At, B0); PG8_BAR; PG8_SCHED;
            PG8_LDB(B1, 0, 1); PG8_STAGE(PG8_SB(0, 0), b2, voffB);
            PG8_BAR; PG8_WAIT_L(0); PG8_MMA(0, 1, At, B1); PG8_BAR;
            PG8_LDA(At, 0, 1); PG8_STAGE(PG8_SA(0, 0), a2, voffA);
            PG8_BAR; PG8_WAIT_L(0); PG8_MMA(1, 0, At, B0); PG8_BAR; PG8_SCHED;
            PG8_STAGE(PG8_SB(0, 1), b2 + hstep, voffB);
            PG8_WAIT_V(6); PG8_BAR; PG8_MMA(1, 1, At, B1); PG8_BAR;
            PG8_LDB(B0, 1, 0); PG8_SCHED; PG8_LDA(At, 1, 0); PG8_STAGE(PG8_SA(0, 1), a2 + hstep, voffA);
            PG8_WAIT_L(8); PG8_BAR; PG8_WAIT_L(0); PG8_MMA(0, 0, At, B0); PG8_BAR; PG8_SCHED;
            PG8_LDB(B1, 1, 1); PG8_STAGE(PG8_SB(1, 0), b3, voffB);
            PG8_BAR; PG8_WAIT_L(0); PG8_MMA(0, 1, At, B1); PG8_BAR;
            PG8_LDA(At, 1, 1); PG8_STAGE(PG8_SA(1, 0), a3, voffA);
            PG8_BAR; PG8_WAIT_L(0); PG8_MMA(1, 0, At, B0); PG8_BAR; PG8_SCHED;
            PG8_STAGE(PG8_SB(1, 1), b3 + hstep, voffB);
            PG8_WAIT_V(6); PG8_BAR; PG8_MMA(1, 1, At, B1); PG8_BAR;
            }
        }
        if constexpr (ALIGN_EPI) { if (wr == 0) PG8_BAR; }
        if constexpr (!Epi::AFTER_DRAIN) { E(acc, cur, wr, wc, fr, fq); S.done(cur); }
        if (!has_next) break;
#pragma unroll
        for (int a = 0; a < 2; ++a)
#pragma unroll
            for (int b = 0; b < 2; ++b)
#pragma unroll
                for (int m = 0; m < 4; ++m)
#pragma unroll
                    for (int n = 0; n < 2; ++n) acc[a][b][m][n] = (f32x4){0.f, 0.f, 0.f, 0.f};
        cur = nxt; cA = nA; cB = nB; ++ui;
        if constexpr (ALIGN_EPI) { if (wr == 1) PG8_BAR; }
    }
    PG8_WAIT_V(0);
    if constexpr (!ALIGN_EPI) { if (wr == 0) PG8_BAR; }
    PG8_BAR;
    if constexpr (Epi::AFTER_DRAIN) { E.fused(acc, cur, wr, wc, fr, fq, lds, wid, lane); S.done(cur); }
#undef PG8_SA
#undef PG8_SB
#undef PG8_STAGE
#undef PG8_LDA
#undef PG8_LDB
#undef PG8_MMA
#undef PG8_WAIT_V
#undef PG8_WAIT_L
#undef PG8_BAR
#undef PG8_SCHED
}
}

#define GAS __attribute__((address_space(1)))
#define LAS __attribute__((address_space(3)))
using pg8::bf16_t; using pg8::bf16x8; using pg8::f32x4; using pg8::u32x4;
typedef unsigned u32x2 __attribute__((ext_vector_type(2)));
typedef float f32x16 __attribute__((ext_vector_type(16)));
constexpr int DM = 1024, NPR = 16384, NSR = 512, MR = NPR + NSR, DEPTH = 4, INW = 3328, PLE = 256;
constexpr float EPS = 1e-6f, LOG2E = 1.4426950408889634f, QS = 0.125f * 1.4426950408889634f;
constexpr size_t O_NKP = 17301504, O_NVP = 17825792, O_NCP = 18350080, O_NKS = 18382848, O_NVS = 26771456, O_NCS = 35160064, O_END = 35684352;
constexpr size_t MiB = 1u << 20;
constexpr size_t WS_SSP = 0  , WS_TAB = 253 * MiB  , WS_WIN = 2 * MiB, WS_WOUT = 28 * MiB, WS_WPG = 36 * MiB, WS_WPP = 44 * MiB, WS_XB0 = 46 * MiB, WS_PB = 79 * MiB, WS_PP = 112 * MiB,
                 WS_MIX = 145 * MiB, WS_Q = 178 * MiB, WS_SGA = WS_Q + 16 * MiB + MiB / 2, WS_XB1 = WS_Q, WS_BGC = 211 * MiB, WS_U = WS_BGC + 16 * MiB + MiB / 2, WS_K = 244 * MiB,
                 WS_V = WS_K + 4 * MiB + MiB / 8, WS_BAR = 254 * MiB  , WS_END = 255 * MiB;
static_assert(WS_V + 4 * MiB + MiB / 8 <= WS_TAB && WS_TAB + 2052 * 64 * 4 <= WS_BAR && (size_t)MR * 16 * 4 <= 2 * MiB && WS_END <= 256 * MiB, "ws map");
constexpr int LDS_BYTES = 147456;
template <class T, class P> __device__ __forceinline__ T gld(P p) { return *(GAS const T*)p; }
template <class T, class P> __device__ __forceinline__ void gst(P p, T v) { *(GAS T*)p = v; }
template <class T, class P> __device__ __forceinline__ void gst_nt(P p, T v) { __builtin_nontemporal_store(v, (GAS T*)p); }
template <class T, class P> __device__ __forceinline__ T gld_nt(P p) { return __builtin_nontemporal_load((GAS const T*)p); }

__device__ __forceinline__ unsigned pk2(float lo, float hi) { return pg8::cvt_pk_bf16(lo, hi); }
__device__ __forceinline__ u32x4 pk8(f32x4 a, f32x4 b) { u32x4 w; w.x = pk2(a[0], a[1]); w.y = pk2(a[2], a[3]); w.z = pk2(b[0], b[1]); w.w = pk2(b[2], b[3]); return w; }
__device__ __forceinline__ u32x2 pk4(f32x4 a) { u32x2 w; w.x = pk2(a[0], a[1]); w.y = pk2(a[2], a[3]); return w; }
__device__ __forceinline__ float bflo(unsigned w) { return __uint_as_float(w << 16); }
__device__ __forceinline__ float bfhi(unsigned w) { return __uint_as_float(w & 0xffff0000u); }
__device__ __forceinline__ float sigm(float x) { return __builtin_amdgcn_rcpf(1.f + __builtin_amdgcn_exp2f(-x * LOG2E)); }
__device__ __forceinline__ f32x4 silu4(f32x4 x) { f32x4 r; for (int i = 0; i < 4; ++i) r[i] = x[i] * sigm(x[i]); return r; }
__device__ __forceinline__ f32x4 sigm4(f32x4 x) { f32x4 r; for (int i = 0; i < 4; ++i) r[i] = sigm(x[i]); return r; }
__device__ __forceinline__ float row_rs(const float* ssp, int row, int fq) {
    const f32x4 v = gld<f32x4>(ssp + (size_t)row * 16 + fq * 4); float s = (v[0] + v[1]) + (v[2] + v[3]);
    s += __shfl_xor(s, 16); s += __shfl_xor(s, 32);
    return __builtin_amdgcn_rsqf(s * (1.f / 1024.f) + EPS);
}


typedef __attribute__((address_space(4))) const unsigned char* kptr_t;
__device__ __forceinline__ unsigned long long ka_u64(int off) { kptr_t p = (kptr_t)__builtin_amdgcn_kernarg_segment_ptr(); asm volatile("" : "+s"(p)); return *(__attribute__((address_space(4))) const unsigned long long*)(p + off); }
__device__ __forceinline__ const float* ka_in(int k) { return (const float*)(GAS const float*)ka_u64(8 * k); }
__device__ __forceinline__ float* ka_out() { return (float*)(GAS float*)ka_u64(120); }
__device__ __forceinline__ unsigned char* ka_ws() { return (unsigned char*)(GAS unsigned char*)ka_u64(128); }

struct EpiIn {
    static constexpr bool PERM = true, AFTER_DRAIN = false;
    int L;
    struct Ld { f32x4 ss, c0, c1, s0, s1; };
    __device__ __forceinline__ void operator()(const f32x4 (&acc)[2][2][4][2], const pg8::Unit& u, int wr, int wc, int fr_, int fq_) const {
        int lane_ = fr_ + 16 * fq_; asm volatile("" : "+v"(lane_)); const int fr = lane_ & 15, fq = lane_ >> 4;
        const int pn = u.pn; unsigned char* ws = ka_ws(); float* out = ka_out();
        const float* ssp = (const float*)(ws + WS_SSP); const float* tab = (const float*)(ws + WS_TAB);
        bf16_t *Q = (bf16_t*)(ws + WS_Q), *K = (bf16_t*)(ws + WS_K), *V = (bf16_t*)(ws + WS_V), *SGA = (bf16_t*)(ws + WS_SGA), *BGC = (bf16_t*)(ws + WS_BGC), *U = (bf16_t*)(ws + WS_U);
        const bool rope = pn < 2 || (pn == 2 && wc < 2);
        const int row0 = u.pm * 256 + wr * 64 + fr, cw = wc * 32 + fq * 8;
        Ld ld[8];
#pragma unroll
        for (int it = 0; it < 10; ++it) {
            if (it < 8) {
                const int row = row0 + (it >> 2) * 128 + (it & 3) * 16;
                ld[it].ss = gld<f32x4>(ssp + (size_t)row * 16 + fq * 4);
                if (rope) { const int pidx = row < NPR ? (row & 2047) : 2048 + (row & 3); const float* tp = tab + (size_t)pidx * 64 + fq * 8;
                    ld[it].c0 = gld<f32x4>(tp); ld[it].c1 = gld<f32x4>(tp + 4); ld[it].s0 = gld<f32x4>(tp + 32); ld[it].s1 = gld<f32x4>(tp + 36); }
            }
            if (it >= 2) {
                const int k = it - 2, ai = k >> 2, m = k & 3, row = row0 + ai * 128 + m * 16;
                float sq = (ld[k].ss[0] + ld[k].ss[1]) + (ld[k].ss[2] + ld[k].ss[3]); sq += __shfl_xor(sq, 16); sq += __shfl_xor(sq, 32);
                const float rs = __builtin_amdgcn_rsqf(sq * (1.f / 1024.f) + EPS);
                const f32x4 a0 = acc[ai][0][m][0] * rs, a1 = acc[ai][0][m][1] * rs, b0 = acc[ai][1][m][0] * rs, b1 = acc[ai][1][m][1] * rs;
                if (rope) {
                    const f32x4 c0 = ld[k].c0, c1 = ld[k].c1, s0 = ld[k].s0, s1 = ld[k].s1;
                    f32x4 o1a = a0 * c0 - b0 * s0, o1b = a1 * c1 - b1 * s1, o2a = b0 * c0 + a0 * s0, o2b = b1 * c1 + a1 * s1;
                    if (pn < 2) {
                        o1a *= QS; o1b *= QS; o2a *= QS; o2b *= QS;
                        bf16_t* q = Q + (size_t)row * 512 + (4 * pn + wc) * 64 + fq * 8;
                        gst<u32x4>(q, pk8(o1a, o1b)); gst<u32x4>(q + 32, pk8(o2a, o2b));
                    } else {
                        bf16_t* kk = K + (size_t)row * 128 + wc * 64 + fq * 8;
                        gst<u32x4>(kk, pk8(o1a, o1b)); gst<u32x4>(kk + 32, pk8(o2a, o2b));
                        const bool smp = row >= NPR; const bool wr_out = smp || (row & 2047) >= 1920;
                        const size_t kofs = smp ? O_NKS + ((size_t)(L * 128 + ((row - NPR) >> 2)) * 128 + 124 + (row & 3)) * 128 : O_NKP + ((size_t)(L * 8 + (row >> 11)) * 128 + ((row & 2047) - 1920)) * 128;
                        if (wr_out) { float* ko = out + kofs + wc * 64 + fq * 8; gst<f32x4>(ko, o1a); gst<f32x4>(ko + 4, o1b); gst<f32x4>(ko + 32, o2a); gst<f32x4>(ko + 36, o2b); }
                    }
                } else if (pn == 2) {
                    bf16_t* v = V + (size_t)row * 128 + (wc - 2) * 32 + fq * 8;
                    gst<u32x4>(v, pk8(a0, a1)); gst<u32x4>(v + 64, pk8(b0, b1));
                    const bool smp = row >= NPR; const bool wr_out = smp || (row & 2047) >= 1920;
                    const size_t vofs = smp ? O_NVS + ((size_t)(L * 128 + ((row - NPR) >> 2)) * 128 + 124 + (row & 3)) * 128 : O_NVP + ((size_t)(L * 8 + (row >> 11)) * 128 + ((row & 2047) - 1920)) * 128;
                    if (wr_out) { float* vo = out + vofs + (wc - 2) * 32 + fq * 8; gst<f32x4>(vo, a0); gst<f32x4>(vo + 4, a1); gst<f32x4>(vo + 64, b0); gst<f32x4>(vo + 68, b1); }
                } else if (pn < 5) {
                    bf16_t* p = SGA + (size_t)row * 512 + (pn - 3) * 256 + cw;
                    gst<u32x4>(p, pk8(silu4(a0), silu4(a1))); gst<u32x4>(p + 128, pk8(silu4(b0), silu4(b1)));
                } else if (pn < 9) {
                    bf16_t* p = BGC + (size_t)row * 512 + (pn - 5) * 128 + cw;
                    gst<u32x4>(p, pk8(a0 * silu4(b0), a1 * silu4(b1)));
                } else {
                    const f32x4 u0 = a0 * b0, u1 = a1 * b1; const int c = (pn - 9) * 128 + cw;
                    gst<u32x4>(U + (size_t)row * 512 + c, pk8(u0, u1));
                    const bool smp = row >= NPR; const bool wr_out = smp ? (row & 3) >= 2 : (row & 2047) >= 2046;
                    const size_t uofs = smp ? O_NCS + ((size_t)(L * 128 + ((row - NPR) >> 2)) * 2 + ((row & 3) - 2)) * 512 : O_NCP + ((size_t)(L * 8 + (row >> 11)) * 2 + ((row & 2047) - 2046)) * 512;
                    if (wr_out) { float* uo = out + uofs + c; gst<f32x4>(uo, u0); gst<f32x4>(uo + 4, u1); }
                }
            }
        }
    }
};
struct EpiPP {
    static constexpr bool PERM = true, AFTER_DRAIN = false;
    int dummy;
    __device__ __forceinline__ void operator()(const f32x4 (&acc)[2][2][4][2], const pg8::Unit& u, int wr, int wc, int fr_, int fq_) const {
        int lane_ = fr_ + 16 * fq_; asm volatile("" : "+v"(lane_)); const int fr = lane_ & 15, fq = lane_ >> 4;
        bf16_t* O = (bf16_t*)(ka_ws() + WS_PP);
#pragma unroll
        for (int ai = 0; ai < 2; ++ai)
#pragma unroll
            for (int m = 0; m < 4; ++m) {
                bf16_t* p = O + (size_t)(u.pm * 256 + ai * 128 + wr * 64 + m * 16 + fr) * DM + u.pn * 256 + wc * 32 + fq * 8;
                *(u32x4*)p = pk8(acc[ai][0][m][0], acc[ai][0][m][1]); gst<u32x4>(p + 128, pk8(acc[ai][1][m][0], acc[ai][1][m][1]));
            }
    }
};
__device__ __forceinline__ f32x4 bf4(u32x2 w) { return (f32x4){bflo(w.x), bfhi(w.x), bflo(w.y), bfhi(w.y)}; }
struct EpiOut {
    static constexpr bool PERM = true, AFTER_DRAIN = false;
    int dummy;
    __device__ __forceinline__ void operator()(const f32x4 (&acc)[2][2][4][2], const pg8::Unit& u, int wr, int wc, int fr_, int fq_) const {
        int lane_ = fr_ + 16 * fq_; asm volatile("" : "+v"(lane_)); const int fr = lane_ & 15, fq = lane_ >> 4;
        unsigned char* ws = ka_ws(); const bf16_t* X0 = (const bf16_t*)(ws + WS_XB0); bf16_t* X1 = (bf16_t*)(ws + WS_XB1);
        const int row0 = u.pm * 256 + wr * 64 + fr, col0 = u.pn * 256 + wc * 32 + fq * 8;
        u32x4 xr[8][2];
#pragma unroll
        for (int it = 0; it < 10; ++it) {
            if (it < 8) { const size_t off = (size_t)(row0 + (it >> 2) * 128 + (it & 3) * 16) * DM + col0;
#pragma unroll
                for (int bj = 0; bj < 2; ++bj) xr[it][bj] = gld<u32x4>(X0 + off + bj * 128); }
            if (it >= 2) { const int k = it - 2, ai = k >> 2, m = k & 3; const size_t off = (size_t)(row0 + ai * 128 + m * 16) * DM + col0;
#pragma unroll
                for (int bj = 0; bj < 2; ++bj) { const u32x4 w = xr[k][bj];
                    gst<u32x4>(X1 + off + bj * 128, pk8(bf4((u32x2){w.x, w.y}) + acc[ai][bj][m][0], bf4((u32x2){w.z, w.w}) + acc[ai][bj][m][1])); } }
        }
    }
    __device__ __forceinline__ void small(f32x4 acc, int row, int col, int chunk) const {
        unsigned char* ws = ka_ws(); const bf16_t* X0 = (const bf16_t*)(ws + WS_XB0); bf16_t* X1 = (bf16_t*)(ws + WS_XB1);
        gst<u32x2>(X1 + (size_t)row * DM + col, pk4(bf4(gld<u32x2>(X0 + (size_t)row * DM + col)) + acc));
    }
};
struct EpiGate {
    static constexpr bool PERM = true, AFTER_DRAIN = false;
    int dummy;
    __device__ __forceinline__ void operator()(const f32x4 (&acc)[2][2][4][2], const pg8::Unit& u, int wr, int wc, int fr_, int fq_) const {
        int lane_ = fr_ + 16 * fq_; asm volatile("" : "+v"(lane_)); const int fr = lane_ & 15, fq = lane_ >> 4;
        unsigned char* ws = ka_ws(); const bf16_t* X1 = (const bf16_t*)(ws + WS_XB1); bf16_t* X0 = (bf16_t*)(ws + WS_XB0); const bf16_t* PP = (const bf16_t*)(ws + WS_PP); float* ssp = (float*)(ws + WS_SSP);
        const int row0 = u.pm * 256 + wr * 64 + fr, col0 = u.pn * 256 + wc * 32 + fq * 8;
        u32x4 xr[8][2], pr[8][2];
#pragma unroll
        for (int it = 0; it < 10; ++it) {
            if (it < 8) { const size_t off = (size_t)(row0 + (it >> 2) * 128 + (it & 3) * 16) * DM + col0;
#pragma unroll
                for (int bj = 0; bj < 2; ++bj) { xr[it][bj] = gld<u32x4>(X1 + off + bj * 128); pr[it][bj] = gld<u32x4>(PP + off + bj * 128); } }
            if (it >= 2) { const int k = it - 2, ai = k >> 2, m = k & 3, row = row0 + ai * 128 + m * 16; const size_t off = (size_t)row * DM + col0; float sq = 0.f;
#pragma unroll
                for (int bj = 0; bj < 2; ++bj) { const u32x4 xw = xr[k][bj], pw = pr[k][bj];
                    const u32x4 w = pk8(bf4((u32x2){xw.x, xw.y}) + sigm4(acc[ai][bj][m][0]) * bf4((u32x2){pw.x, pw.y}), bf4((u32x2){xw.z, xw.w}) + sigm4(acc[ai][bj][m][1]) * bf4((u32x2){pw.z, pw.w}));
                    gst<u32x4>(X0 + off + bj * 128, w);
                    const f32x4 y0 = bf4((u32x2){w.x, w.y}), y1 = bf4((u32x2){w.z, w.w});
                    sq += ((y0[0] * y0[0] + y0[1] * y0[1]) + (y0[2] * y0[2] + y0[3] * y0[3])) + ((y1[0] * y1[0] + y1[1] * y1[1]) + (y1[2] * y1[2] + y1[3] * y1[3])); }
                sq += __shfl_xor(sq, 16); sq += __shfl_xor(sq, 32);
                if (fq == 0) gst<float>(ssp + (size_t)row * 16 + u.pn * 4 + wc, sq); }
        }
    }
    __device__ __forceinline__ void small(f32x4 acc, int row, int col, int chunk) const {
        unsigned char* ws = ka_ws(); const bf16_t* X1 = (const bf16_t*)(ws + WS_XB1); bf16_t* X0 = (bf16_t*)(ws + WS_XB0); const bf16_t* PP = (const bf16_t*)(ws + WS_PP); float* ssp = (float*)(ws + WS_SSP);
        const u32x2 w = pk4(bf4(gld<u32x2>(X1 + (size_t)row * DM + col)) + sigm4(acc) * bf4(gld<u32x2>(PP + (size_t)row * DM + col))); const f32x4 x2 = bf4(w);
        gst<u32x2>(X0 + (size_t)row * DM + col, w);
        float sq = (x2[0] * x2[0] + x2[1] * x2[1]) + (x2[2] * x2[2] + x2[3] * x2[3]);
        sq += __shfl_xor(sq, 1); sq += __shfl_xor(sq, 2); sq += __shfl_xor(sq, 4); sq += __shfl_xor(sq, 8);
        if ((lane_id() & 15) == 0) gst<float>(ssp + (size_t)row * 16 + chunk, sq);
    }
};
struct FillOrder {
    int nN, nwg, c, rem, stride;
    __device__ void init(int M, int N, int G, int c_, int rem_) { nN = N / 256; nwg = (M / 256) * nN; c = c_; rem = rem_; stride = G - rem_; }
    __device__ bool next(int i, pg8::Unit& u) const { if (c < rem) return false; const int idx = (c - rem) + i * stride; if (idx >= nwg) return false; u.pm = idx / nN; u.pn = idx % nN; return true; }
    __device__ __forceinline__ void a_ready(const pg8::Unit&) const {}
    __device__ __forceinline__ void done(const pg8::Unit&) const {}
};

template <class Epi>
__device__ __forceinline__ void small_gemm(LAS unsigned char* lds, const bf16_t* A, const bf16_t* Bt, const Epi& E, const int w0) {
    int tid_ = TID_OF(w0); asm volatile("" : "+v"(tid_));
    const int tid = tid_, lane = tid & 63, wid = __builtin_amdgcn_readfirstlane(tid >> 6), fr = lane & 15, fq = lane >> 4;
    for (int tile = blockIdx.x; tile < 256; tile += gridDim.x) {
        const int rt = tile >> 4, ct = tile & 15, k0 = wid * 128;
        bf16x8 af[2][4], bw[4][4];
#pragma unroll
        for (int i = 0; i < 2; ++i)
#pragma unroll
            for (int ks = 0; ks < 4; ++ks) af[i][ks] = gld<bf16x8>(A + (size_t)(rt * 32 + i * 16 + fr) * DM + k0 + ks * 32 + fq * 8);
#pragma unroll
        for (int j = 0; j < 4; ++j)
#pragma unroll
            for (int ks = 0; ks < 4; ++ks) bw[j][ks] = gld<bf16x8>(Bt + (size_t)(ct * 64 + j * 16 + fr) * DM + k0 + ks * 32 + fq * 8);
        f32x4 acc[2][4];
#pragma unroll
        for (int i = 0; i < 2; ++i)
#pragma unroll
            for (int j = 0; j < 4; ++j) { acc[i][j] = (f32x4){0.f, 0.f, 0.f, 0.f};
#pragma unroll
                for (int ks = 0; ks < 4; ++ks) acc[i][j] = __builtin_amdgcn_mfma_f32_16x16x32_bf16(bw[j][ks], af[i][ks], acc[i][j], 0, 0, 0); }
        __syncthreads();
#pragma unroll
        for (int i = 0; i < 2; ++i)
#pragma unroll
            for (int j = 0; j < 4; ++j) *(LAS f32x4*)(lds + ((wid * 8 + i * 4 + j) * 64 + lane) * 16) = acc[i][j];
        __syncthreads();
        const int row = tid >> 4, c4 = tid & 15, til = (row >> 4) * 4 + (c4 >> 2), l = (row & 15) + 16 * (c4 & 3);
        f32x4 sum = (f32x4){0.f, 0.f, 0.f, 0.f};
#pragma unroll
        for (int w = 0; w < 8; ++w) sum += *(LAS const f32x4*)(lds + ((w * 8 + til) * 64 + l) * 16);
        E.small(sum, NPR + rt * 32 + row, ct * 64 + c4 * 4, ct);
    }
    __syncthreads();
}

constexpr int KSTR = 144, VSTR = 520, VSTR_S = 328;
constexpr int VOFF = 256 * KSTR, SK_OFF = VOFF + 64 * VSTR, SV_OFF = SK_OFF + 160 * KSTR, P2_LDS_END = SV_OFF + 64 * VSTR_S;
constexpr int STG_OFF = P2_LDS_END;
static_assert(STG_OFF + 8 * 2048 <= 131072, "P2 LDS map");
typedef unsigned long long u64;
template <int VS>
__device__ __forceinline__ void attn_qk(LAS const unsigned char* Kl, const bf16x8 (&qf)[4], int kt0, int qi, int kjmin, float sink2, int lane, f32x16 (&s)[5], float& inv_l) {
    asm volatile("" : "+v"(qi), "+v"(lane));
    const int l31 = lane & 31, hi = lane >> 5;
#pragma unroll
    for (int ti = 0; ti < 5; ++ti) {
        f32x16 a = {};
#pragma unroll
        for (int c = 0; c < 4; ++c) { const bf16x8 kf = *(LAS const bf16x8*)(Kl + (32 * (kt0 + ti) + l31) * KSTR + (16 * c + 8 * hi) * 2); a = __builtin_amdgcn_mfma_f32_32x32x16_bf16(kf, qf[c], a, 0, 0, 0); }
        s[ti] = a;
    }
    float mx = sink2;
    const int kj0 = 32 * kt0 + 4 * hi, lo_ = max(qi + 1, kjmin), dA = kj0 - lo_, dB = qi + 128 - kj0;
    if (kjmin > 0) {
#pragma unroll
        for (int ti = 0; ti < 5; ++ti)
#pragma unroll
            for (int r = 0; r < 16; ++r) { const int cc = 32 * ti + (r & 3) + 8 * (r >> 2); const int mm = min(dA + cc, dB - cc);
                const float v = s[ti][r] + __int_as_float((mm >> 31) & (int)0xF149F2CAu); s[ti][r] = v; mx = fmaxf(mx, v); }
    } else {
#pragma unroll
        for (int ti = 0; ti < 5; ++ti)
#pragma unroll
            for (int r = 0; r < 16; ++r) { float v = s[ti][r];
                if (ti == 0 || ti == 4) { const int cc = 32 * ti + (r & 3) + 8 * (r >> 2); const int mm = min(dA + cc, dB - cc); v += __int_as_float((mm >> 31) & (int)0xF149F2CAu); s[ti][r] = v; }
                mx = fmaxf(mx, v); }
    }
    mx = fmaxf(mx, __shfl_xor(mx, 32));
    float l = 0.f;
#pragma unroll
    for (int ti = 0; ti < 5; ++ti)
#pragma unroll
        for (int r = 0; r < 16; ++r) { const float p = __builtin_amdgcn_exp2f(s[ti][r] - mx); s[ti][r] = p; l += p; }
    l += __shfl_xor(l, 32); l += __builtin_amdgcn_exp2f(sink2 - mx);
    inv_l = __builtin_amdgcn_rcpf(l);
}
template <int VS>
__device__ __forceinline__ void attn_pv(LAS const unsigned char* Vl, const f32x16 (&s)[5], int kt0, int lane, f32x16 (&o)[2]) {
    const int l31 = lane & 31, hi = lane >> 5;
    o[0] = (f32x16){}; o[1] = (f32x16){};
#pragma unroll
    for (int ti = 0; ti < 5; ++ti)
#pragma unroll
        for (int c2 = 0; c2 < 2; ++c2) {
            u32x4 pw; pw.x = pk2(s[ti][8 * c2 + 0], s[ti][8 * c2 + 1]); pw.y = pk2(s[ti][8 * c2 + 2], s[ti][8 * c2 + 3]); pw.z = pk2(s[ti][8 * c2 + 4], s[ti][8 * c2 + 5]); pw.w = pk2(s[ti][8 * c2 + 6], s[ti][8 * c2 + 7]);
            const bf16x8 pf = __builtin_bit_cast(bf16x8, pw);
            const int kb = 32 * (kt0 + ti) + 16 * c2 + 4 * hi;
#pragma unroll
            for (int dh = 0; dh < 2; ++dh) {
                const u64 lo = *(LAS const u64*)(Vl + (32 * dh + l31) * VS + kb * 2), hi8 = *(LAS const u64*)(Vl + (32 * dh + l31) * VS + (kb + 8) * 2);
                u32x4 vw; vw.x = (unsigned)lo; vw.y = (unsigned)(lo >> 32); vw.z = (unsigned)hi8; vw.w = (unsigned)(hi8 >> 32);
                o[dh] = __builtin_amdgcn_mfma_f32_32x32x16_bf16(__builtin_bit_cast(bf16x8, vw), pf, o[dh], 0, 0, 0);
            }
        }
}
template <int VS, bool SMP>
__device__ __forceinline__ void attn_job(LAS const unsigned char* Kl, LAS const unsigned char* Vl, LAS unsigned char* stg, const bf16_t* Q, const bf16_t* SGA, bf16_t* MIX, size_t row0, int head0, int kt0, int qi, int kjmin, float sink2, int lane) {
    const int l31 = lane & 31, hi = lane >> 5;
    const size_t qrow = SMP ? row0 + ((l31 >> 2) & 3) : row0 + l31; const int qhead = SMP ? head0 + (l31 & 3) : head0;
    bf16x8 qf[4];
#pragma unroll
    for (int c = 0; c < 4; ++c) { qf[c] = gld<bf16x8>(Q + qrow * 512 + qhead * 64 + 16 * c + 8 * hi); if (SMP && l31 >= 16) qf[c] = (bf16x8){0, 0, 0, 0, 0, 0, 0, 0}; }
    f32x16 s[5], o[2]; float inv_l;
    attn_qk<VS>(Kl, qf, kt0, qi, kjmin, sink2, lane, s, inv_l);
    const int ch = lane & 3; size_t grow[2]; int gcol[2]; u32x4 g[2][2];
#pragma unroll
    for (int i = 0; i < 2; ++i) { const int rr = (lane >> 2) + 16 * i;
        grow[i] = SMP ? row0 + (rr >> 2) : row0 + rr; gcol[i] = (SMP ? head0 + (rr & 3) : head0) * 64 + 8 * ch;
#pragma unroll
        for (int dh = 0; dh < 2; ++dh) g[i][dh] = (SMP && i == 1) ? (u32x4){0u, 0u, 0u, 0u} : gld<u32x4>(SGA + grow[i] * 512 + gcol[i] + 32 * dh); }
    attn_pv<VS>(Vl, s, kt0, lane, o);
    const int fq = (l31 >> 1) & 3;
#pragma unroll
    for (int dh = 0; dh < 2; ++dh) {
#pragma unroll
        for (int r4 = 0; r4 < 4; ++r4) { f32x4 v; v[0] = o[dh][4 * r4 + 0] * inv_l; v[1] = o[dh][4 * r4 + 1] * inv_l; v[2] = o[dh][4 * r4 + 2] * inv_l; v[3] = o[dh][4 * r4 + 3] * inv_l;
            *(LAS u32x2*)(stg + l31 * 64 + ((r4 ^ fq) * 16) + 8 * hi) = pk4(v); }
        asm volatile("s_waitcnt lgkmcnt(0)" ::: "memory");
#pragma unroll
        for (int i = 0; i < 2; ++i) { if (SMP && i == 1) continue;
            const int rr = (lane >> 2) + 16 * i; const u32x4 w = *(LAS const u32x4*)(stg + rr * 64 + ((ch ^ ((rr >> 1) & 3)) * 16)); const u32x4 gg = g[i][dh];
            u32x4 r; r.x = pk2(bflo(w.x) * bflo(gg.x), bfhi(w.x) * bfhi(gg.x)); r.y = pk2(bflo(w.y) * bflo(gg.y), bfhi(w.y) * bfhi(gg.y)); r.z = pk2(bflo(w.z) * bflo(gg.z), bfhi(w.z) * bfhi(gg.z)); r.w = pk2(bflo(w.w) * bflo(gg.w), bfhi(w.w) * bfhi(gg.w));
            gst<u32x4>(MIX + grow[i] * 1024 + gcol[i] + 32 * dh, r); }
        asm volatile("s_waitcnt lgkmcnt(0)" ::: "memory");
    }
}
__device__ __forceinline__ void unpack8(u32x4 w, float (&f)[8]) { f[0] = bflo(w.x); f[1] = bfhi(w.x); f[2] = bflo(w.y); f[3] = bfhi(w.y); f[4] = bflo(w.z); f[5] = bfhi(w.z); f[6] = bflo(w.w); f[7] = bfhi(w.w); }
template <int NT>
__device__ __forceinline__ void conv_rows(const bf16_t* U, const bf16_t* BGC, bf16_t* MIX, const float* cw, size_t row0, int c0, float (&p2v)[8], float (&p1v)[8]) {
    float w0[8], w1[8], w2[8];
#pragma unroll
    for (int e = 0; e < 8; ++e) { w0[e] = gld<float>(cw + e); w1[e] = gld<float>(cw + 512 + e); w2[e] = gld<float>(cw + 1024 + e); }
    u32x4 ur[NT], br[NT];
#pragma unroll
    for (int i = 0; i < NT; ++i) { ur[i] = gld<u32x4>(U + (row0 + i) * 512 + c0); br[i] = gld<u32x4>(BGC + (row0 + i) * 512 + c0); }
#pragma unroll
    for (int i = 0; i < NT; ++i) {
        float uc[8], bg[8], y[8]; unpack8(ur[i], uc); unpack8(br[i], bg);
#pragma unroll
        for (int e = 0; e < 8; ++e) { y[e] = bg[e] * (w0[e] * p2v[e] + w1[e] * p1v[e] + w2[e] * uc[e]); p2v[e] = p1v[e]; p1v[e] = uc[e]; }
        u32x4 w; w.x = pk2(y[0], y[1]); w.y = pk2(y[2], y[3]); w.z = pk2(y[4], y[5]); w.w = pk2(y[6], y[7]);
        gst<u32x4>(MIX + (row0 + i) * 1024 + 512 + c0, w);
    }
}

struct P2Args { const bf16_t *Q, *K, *V, *SGA, *BGC, *U; bf16_t* MIX; const float *cache_k, *cache_v, *state, *sinks, *conv_w; float* out; };
__device__ __forceinline__ P2Args p2_args() { unsigned char* ws = ka_ws(); return P2Args{(const bf16_t*)(ws + WS_Q), (const bf16_t*)(ws + WS_K), (const bf16_t*)(ws + WS_V), (const bf16_t*)(ws + WS_SGA), (const bf16_t*)(ws + WS_BGC), (const bf16_t*)(ws + WS_U), (bf16_t*)(ws + WS_MIX), ka_in(2), ka_in(3), ka_in(4), ka_in(9), ka_in(10), ka_out()}; }
__device__ __forceinline__ void p2_phase(LAS unsigned char* lds, const int L, const int w0) {
    int tid_ = TID_OF(w0); asm volatile("" : "+v"(tid_));
    const int wid = __builtin_amdgcn_readfirstlane(tid_ >> 6);
#define P2_RELAUNDER() int tid = tid_; asm volatile("" : "+v"(tid)); const int lane = tid & 63, l31 = lane & 31; (void)l31; (void)lane
    LAS unsigned short* vt = (LAS unsigned short*)(lds + VOFF); LAS unsigned short* svt = (LAS unsigned short*)(lds + SV_OFF);
    for (int item = blockIdx.x; item < 256; item += gridDim.x) {
        const P2Args A = p2_args();
        const int b = item >> 5, n = (item >> 1) & 15, kvh = item & 1, sb = item >> 1;
        const size_t cb = ((size_t)(L * 128 + sb) * 128) * 128 + kvh * 64;
        __syncthreads();
        {
            P2_RELAUNDER();
            u32x4 kv[4], vv[4]; f32x4 kq[4], vq[4];
#pragma unroll
            for (int it = 0; it < 4; ++it) {
                const int idx = it * 512 + tid, kj = idx >> 3, ch = idx & 7, kp = 128 * (n - 1) + kj;
                kv[it] = (u32x4){0u, 0u, 0u, 0u}; vv[it] = (u32x4){0u, 0u, 0u, 0u};
                if (kp >= 0) { const size_t r = (size_t)(b * 2048 + kp); kv[it] = gld<u32x4>(A.K + r * 128 + kvh * 64 + ch * 8); vv[it] = gld<u32x4>(A.V + r * 128 + kvh * 64 + ch * 8); }
                const int j = idx >> 4, c16 = idx & 15;
                kq[it] = gld_nt<f32x4>(A.cache_k + cb + (size_t)j * 128 + c16 * 4); vq[it] = gld_nt<f32x4>(A.cache_v + cb + (size_t)j * 128 + c16 * 4);
            }
#pragma unroll
            for (int it = 0; it < 4; ++it) {
                const int idx = it * 512 + tid, kj = idx >> 3, ch = idx & 7;
                *(LAS u32x4*)(lds + kj * KSTR + ch * 16) = kv[it];
#pragma unroll
                for (int e = 0; e < 8; ++e) { const unsigned w = vv[it][e >> 1]; vt[(ch * 8 + e) * (VSTR / 2) + kj] = (unsigned short)((e & 1) ? (w >> 16) : (w & 0xffffu)); }
                const int j = idx >> 4, c16 = idx & 15;
                *(LAS u32x2*)(lds + SK_OFF + j * KSTR + c16 * 8) = pk4(kq[it]);
                const u32x2 vw = pk4(vq[it]);
                svt[(c16 * 4 + 0) * (VSTR_S / 2) + j] = (unsigned short)(vw.x & 0xffffu); svt[(c16 * 4 + 1) * (VSTR_S / 2) + j] = (unsigned short)(vw.x >> 16);
                svt[(c16 * 4 + 2) * (VSTR_S / 2) + j] = (unsigned short)(vw.y & 0xffffu); svt[(c16 * 4 + 3) * (VSTR_S / 2) + j] = (unsigned short)(vw.y >> 16);
            }
            if (tid < 32) {
                const int t = tid >> 3, ch = tid & 7; const size_t r = (size_t)(NPR + 4 * sb + t);
                const u32x4 k4 = gld<u32x4>(A.K + r * 128 + kvh * 64 + ch * 8), v4 = gld<u32x4>(A.V + r * 128 + kvh * 64 + ch * 8);
                *(LAS u32x4*)(lds + SK_OFF + (128 + t) * KSTR + ch * 16) = k4;
#pragma unroll
                for (int e = 0; e < 8; ++e) { const unsigned w = v4[e >> 1]; svt[(ch * 8 + e) * (VSTR_S / 2) + 128 + t] = (unsigned short)((e & 1) ? (w >> 16) : (w & 0xffffu)); }
            }
            { unsigned z = 0u; asm volatile("" : "+v"(z));
              if (tid < 252) *(LAS u32x4*)(lds + SK_OFF + 132 * KSTR + tid * 16) = (u32x4){z, z, z, z};
              if (tid < 448) { const int d = tid / 7, q = tid % 7; *(LAS u32x2*)(lds + SV_OFF + d * VSTR_S + 264 + q * 8) = (u32x2){z, z}; } }
        }
        __syncthreads();
        {
            P2_RELAUNDER();
            const int head = 4 * kvh + (wid >> 1); const float sink2 = gld<float>(A.sinks + L * 8 + head) * LOG2E;
#pragma unroll 1
            for (int aa = 0; aa < 2; ++aa) {
                const int a = 2 * (wid & 1) + aa; const size_t row0 = (size_t)(b * 2048 + 128 * n + 32 * a);
                attn_job<VSTR, false>(lds, lds + VOFF, lds + STG_OFF + wid * 2048, A.Q, A.SGA, A.MIX, row0, head, a, 32 * a + l31, n == 0 ? 128 : 0, sink2, lane);
            }
        }
        if (wid == 0) {
            P2_RELAUNDER();
            const int t = (l31 >> 2) & 3, head = 4 * kvh + (l31 & 3); const float sink2 = gld<float>(A.sinks + L * 8 + head) * LOG2E;
            attn_job<VSTR_S, true>(lds + SK_OFF, lds + SV_OFF, lds + STG_OFF, A.Q, A.SGA, A.MIX, (size_t)(NPR + 4 * sb), 4 * kvh, 0, t, 0, sink2, lane);
        } else {
            P2_RELAUNDER();
            const int hw = (wid - 1) * 2 + (lane >> 5), c0 = 256 * kvh + 8 * l31; const float* cw = A.conv_w + (size_t)L * 3 * 512 + c0;
#pragma unroll 1
            for (int un = hw; un < 17; un += 14) {
                float p2v[8], p1v[8];
                if (un < 16) {
                    const int t0 = 128 * n + 8 * un; const size_t rb = (size_t)b * 2048;
#pragma unroll
                    for (int e = 0; e < 8; ++e) { p2v[e] = 0.f; p1v[e] = 0.f; }
                    if (t0 >= 2) { unpack8(gld<u32x4>(A.U + (rb + t0 - 2) * 512 + c0), p2v); unpack8(gld<u32x4>(A.U + (rb + t0 - 1) * 512 + c0), p1v); }
                    conv_rows<8>(A.U, A.BGC, A.MIX, cw, rb + t0, c0, p2v, p1v);
                } else {
                    const float* st = A.state + ((size_t)(L * 128 + sb) * 2) * 512 + c0;
#pragma unroll
                    for (int e = 0; e < 8; ++e) { p2v[e] = gld<float>(st + e); p1v[e] = gld<float>(st + 512 + e); }
                    conv_rows<4>(A.U, A.BGC, A.MIX, cw, (size_t)(NPR + 4 * sb), c0, p2v, p1v);
                }
            }
        }
    }
    __syncthreads();
#undef P2_RELAUNDER
}

__device__ __forceinline__ float wave_sum(float v) {
#pragma unroll
    for (int o = 1; o < 64; o <<= 1) v += __shfl_xor(v, o);
    return v;
}
__device__ __forceinline__ int win_src_col(int nb) {
    const int pn = nb >> 3, q = nb & 7, bj = q >> 2, wc = q & 3;
    if (pn < 2) return (4 * pn + wc) * 64 + 32 * bj;
    if (pn == 2) return wc < 2 ? 512 + wc * 64 + 32 * bj : 640 + 64 * bj + (wc - 2) * 32;
    if (pn < 5) return 768 + (pn - 3) * 256 + q * 32;
    if (pn < 9) return (bj == 0 ? 1280 : 2816) + 128 * (pn - 5) + wc * 32;
    return (bj == 0 ? 1792 : 2304) + 128 * (pn - 9) + wc * 32;
}
__device__ __forceinline__ void tr_item64(const float* W, int N, int K, int src_a, int src_b, const float* g, bf16_t* WT, int dst_row0, int k0, LAS float* scr, int lane) {
    const int sc = (lane < 32 ? src_a : src_b) + (lane & 31);
    float v[64];
#pragma unroll
    for (int kk = 0; kk < 64; ++kk) v[kk] = gld_nt<float>(W + (size_t)(k0 + kk) * N + sc);
#pragma unroll
    for (int kk = 0; kk < 64; ++kk) scr[kk * 65 + lane] = g ? v[kk] * gld<float>(g + k0 + kk) : v[kk];
    asm volatile("s_waitcnt lgkmcnt(0)" ::: "memory");
    const int c = lane & 7;
#pragma unroll
    for (int j = 0; j < 8; ++j) { const int n = (lane >> 3) + 8 * j; const LAS float* sp = scr + (8 * c) * 65 + n;
        u32x4 o; o.x = pk2(sp[0 * 65], sp[1 * 65]); o.y = pk2(sp[2 * 65], sp[3 * 65]); o.z = pk2(sp[4 * 65], sp[5 * 65]); o.w = pk2(sp[6 * 65], sp[7 * 65]);
        gst<u32x4>(WT + (size_t)(dst_row0 + n) * K + k0 + 8 * c, o); }
    asm volatile("s_waitcnt lgkmcnt(0)" ::: "memory");
}
struct Args { const float* in[15]; float* out; unsigned char* ws; int ph_lo, ph_hi; };
__device__ __forceinline__ void p0_phase(LAS unsigned char* lds, const Args& a, const int w0) {
    const int tid = TID_OF(w0), lane = tid & 63, wid = __builtin_amdgcn_readfirstlane(tid >> 6);
    const int gw = blockIdx.x * 8 + wid, NGW = gridDim.x * 8;
    LAS float* scr = (LAS float*)(lds + wid * 16640);
    unsigned char* ws = a.ws;
    constexpr int I_IN = DEPTH * 52 * 16, I_SQ = DEPTH * 16 * 16, I_PP = DEPTH * 16 * 4;
    for (int it = gw; it < I_IN + 2 * I_SQ + I_PP; it += NGW) {
        int r = it;
        if (r < I_IN) { const int L = r / (52 * 16), q = r % (52 * 16), nb = q % 52, kb = q / 52;
            tr_item64(a.in[8] + (size_t)L * DM * INW, INW, DM, win_src_col(2 * nb), win_src_col(2 * nb + 1), a.in[7] + L * DM, (bf16_t*)(ws + WS_WIN) + (size_t)L * INW * DM, nb * 64, kb * 64, scr, lane); continue; }
        r -= I_IN;
        if (r < 2 * I_SQ) { const int which = r / I_SQ; r %= I_SQ; const int L = r / 256, q = r % 256, nb = q & 15, kb = q >> 4;
            tr_item64(a.in[which ? 12 : 11] + (size_t)L * DM * DM, DM, DM, nb * 64, nb * 64 + 32, nullptr, (bf16_t*)(ws + (which ? WS_WPG : WS_WOUT)) + (size_t)L * DM * DM, nb * 64, kb * 64, scr, lane); continue; }
        r -= 2 * I_SQ;
        { const int L = r / 64, q = r % 64, nb = q & 15, kb = q >> 4;
            tr_item64(a.in[13] + (size_t)L * PLE * DM, DM, PLE, nb * 64, nb * 64 + 32, nullptr, (bf16_t*)(ws + WS_WPP) + (size_t)L * DM * PLE, nb * 64, kb * 64, scr, lane); }
    }
    for (int row = gw; row < MR; row += 2 * NGW) {
        const int row1 = row + NGW; const bool has1 = row1 < MR; const int r1 = has1 ? row1 : row;
        const float* xr0 = row < NPR ? a.in[0] + (size_t)row * DM : a.in[1] + (size_t)(row - NPR) * DM;
        const float* xr1 = r1 < NPR ? a.in[0] + (size_t)r1 * DM : a.in[1] + (size_t)(r1 - NPR) * DM;
        f32x4 v0[4], v1[4];
#pragma unroll
        for (int j = 0; j < 4; ++j) { v0[j] = gld_nt<f32x4>(xr0 + 4 * lane + 256 * j); v1[j] = gld_nt<f32x4>(xr1 + 4 * lane + 256 * j); }
        float s0 = 0.f, s1 = 0.f;
        bf16_t* xb0 = (bf16_t*)(ws + WS_XB0) + (size_t)row * DM; bf16_t* xb1 = (bf16_t*)(ws + WS_XB0) + (size_t)r1 * DM;
#pragma unroll
        for (int j = 0; j < 4; ++j) { s0 += (v0[j][0] * v0[j][0] + v0[j][1] * v0[j][1]) + (v0[j][2] * v0[j][2] + v0[j][3] * v0[j][3]); s1 += (v1[j][0] * v1[j][0] + v1[j][1] * v1[j][1]) + (v1[j][2] * v1[j][2] + v1[j][3] * v1[j][3]);
            *(u32x2*)(xb0 + 4 * lane + 256 * j) = pk4(v0[j]); if (has1) *(u32x2*)(xb1 + 4 * lane + 256 * j) = pk4(v1[j]); }
        s0 = wave_sum(s0); s1 = wave_sum(s1);
        if (lane < 16) { ((float*)(ws + WS_SSP))[(size_t)row * 16 + lane] = lane == 0 ? s0 : 0.f; if (has1) ((float*)(ws + WS_SSP))[(size_t)row1 * 16 + lane] = lane == 0 ? s1 : 0.f; }
    }
    const int gt = blockIdx.x * 512 + tid, GT = gridDim.x * 512;
    for (int i = gt; i < DEPTH * MR * 64; i += 4 * GT) {
        f32x4 v[4];
#pragma unroll
        for (int j = 0; j < 4; ++j) { const int ii = i + j * GT; const int ic = ii < DEPTH * MR * 64 ? ii : i; const int L = ic / (MR * 64), q = ic % (MR * 64), row = q >> 6, c4 = q & 63;
            const float* src = row < NPR ? a.in[5] + ((size_t)L * NPR + row) * PLE : a.in[6] + ((size_t)L * NSR + row - NPR) * PLE; v[j] = gld_nt<f32x4>(src + c4 * 4); }
#pragma unroll
        for (int j = 0; j < 4; ++j) { const int ii = i + j * GT; if (ii < DEPTH * MR * 64) *(u32x2*)((bf16_t*)(ws + WS_PB) + (size_t)ii * 4) = pk4(v[j]); }
    }
    for (int i = gt; i < 2052 * 32; i += GT) {
        const int pidx = i >> 5, d = i & 31; const double pos = pidx < 2048 ? (double)pidx : (double)(8192 + pidx - 2048);
        double inv = 1.0; for (int k = 0; k < d; ++k) inv *= 0.74989420933245582730;
        double rev = pos * inv * 0.15915494309189533577; rev -= __builtin_floor(rev);
        const float f = (float)rev; float* tp = (float*)(ws + WS_TAB) + (size_t)pidx * 64 + d;
        tp[0] = __builtin_amdgcn_cosf(f); tp[32] = __builtin_amdgcn_sinf(f);
    }
}
__device__ __forceinline__ void final_phase(const int w0) {
    int tid_ = TID_OF(w0); asm volatile("" : "+v"(tid_)); const int tid = tid_, lane = tid & 63, wid = tid >> 6; const int gw = blockIdx.x * 8 + wid, NGW = gridDim.x * 8;
    unsigned char* ws = ka_ws(); const float* ssp = (const float*)(ws + WS_SSP); const bf16_t* X0 = (const bf16_t*)(ws + WS_XB0); const float* gf = ka_in(14); float* outp = ka_out();
    f32x4 g[4];
#pragma unroll
    for (int j = 0; j < 4; ++j) g[j] = gld<f32x4>(gf + 4 * lane + 256 * j);
    for (int row = gw; row < MR; row += 2 * NGW) {
        const int row1 = row + NGW; const bool has1 = row1 < MR; const int r1 = has1 ? row1 : row;
        float s0 = lane < 16 ? gld<float>(ssp + (size_t)row * 16 + lane) : 0.f, s1 = lane < 16 ? gld<float>(ssp + (size_t)r1 * 16 + lane) : 0.f;
        u32x2 v0[4], v1[4];
#pragma unroll
        for (int j = 0; j < 4; ++j) { v0[j] = gld<u32x2>(X0 + (size_t)row * DM + 4 * lane + 256 * j); v1[j] = gld<u32x2>(X0 + (size_t)r1 * DM + 4 * lane + 256 * j); }
        s0 = wave_sum(s0); s1 = wave_sum(s1);
        const float rs0 = __builtin_amdgcn_rsqf(s0 * (1.f / 1024.f) + EPS), rs1 = __builtin_amdgcn_rsqf(s1 * (1.f / 1024.f) + EPS);
#pragma unroll
        for (int j = 0; j < 4; ++j) { gst_nt<f32x4>(outp + (size_t)row * DM + 4 * lane + 256 * j, bf4(v0[j]) * rs0 * g[j]); if (has1) gst_nt<f32x4>(outp + (size_t)row1 * DM + 4 * lane + 256 * j, bf4(v1[j]) * rs1 * g[j]); }
    }
}


__device__ __forceinline__ void copy_cache_window(int L, int tix, int NT) {
    asm volatile("" : "+v"(tix));
    const float* ck = ka_in(2) + (size_t)L * 128 * 128 * 128; const float* cv = ka_in(3) + (size_t)L * 128 * 128 * 128; float* out = ka_out();
    float* ok = out + O_NKS + (size_t)L * 128 * 128 * 128; float* ov = out + O_NVS + (size_t)L * 128 * 128 * 128;
    constexpr int PER_B = 124 * 32;
    constexpr int TOTAL = 128 * PER_B;
    for (int i = tix; i < TOTAL; i += 4 * NT) {
        f32x4 a[4], b[4];
#pragma unroll
        for (int j = 0; j < 4; ++j) { const int ii = i + j * NT; const int ic = ii < TOTAL ? ii : i; const int sb = ic / PER_B, q = ic % PER_B;
            a[j] = gld_nt<f32x4>(ck + ((size_t)sb * 128 + 4) * 128 + (size_t)q * 4); b[j] = gld_nt<f32x4>(cv + ((size_t)sb * 128 + 4) * 128 + (size_t)q * 4); }
#pragma unroll
        for (int j = 0; j < 4; ++j) { const int ii = i + j * NT; if (ii < TOTAL) { const int sb = ii / PER_B, q = ii % PER_B;
            gst_nt<f32x4>(ok + (size_t)sb * 128 * 128 + (size_t)q * 4, a[j]); gst_nt<f32x4>(ov + (size_t)sb * 128 * 128 + (size_t)q * 4, b[j]); } }
    }
}

#define RLX_AGENT __ATOMIC_RELAXED, __HIP_MEMORY_SCOPE_AGENT
#define XB_TMO      128
#define XB_XCNT(j)  (256  + 64 * (j))
#define XB_XSUB(j)  (1280 + 64 * (j))
#define XB_XGEN(j)  (2304 + 64 * (j))
#define XB_TOP      3328
#define XB_TOPGEN   3392
#define XCD_BAR_WORDS 3456
#define XB_SPIN_CAP (1u << 18)

__device__ __forceinline__ unsigned xb_ld(unsigned* p)              { return __hip_atomic_load((GAS unsigned*)p, __ATOMIC_RELAXED, __HIP_MEMORY_SCOPE_AGENT); }
__device__ __forceinline__ unsigned xb_add(unsigned* p, unsigned v) { return __hip_atomic_fetch_add((GAS unsigned*)p, v, __ATOMIC_RELAXED, __HIP_MEMORY_SCOPE_AGENT); }
__device__ __forceinline__ unsigned xb_xcc_id() { return (unsigned)__builtin_amdgcn_s_getreg((3 << 11) | 20) & 0xFu; }
#define XB_SPIN(cond, bar) do { unsigned _sp = 0; while (cond) { __builtin_amdgcn_s_sleep(1); \
    if ((++_sp & 255u) == 0u) { if (xb_ld(&(bar)[XB_TMO])) break; if (_sp > XB_SPIN_CAP) { atomicAdd(&(bar)[XB_TMO], 1u); break; } } } } while (0)

struct XcdBarrier {
    unsigned* bar; unsigned x; int w0;
    volatile LAS unsigned* st;
};

__device__ __forceinline__ XcdBarrier xcd_barrier_post(unsigned* bar, volatile LAS unsigned* st, int w0) {
    XcdBarrier b; b.bar = bar; b.x = xb_xcc_id(); b.st = st; b.w0 = w0;
    if (TID_OF(w0) == 0) (void)xb_add(&bar[XB_XCNT(b.x)], 1u);
    return b;
}
__device__ __forceinline__ void xcd_barrier_complete(unsigned* bar, unsigned x, unsigned& nloc, unsigned& nx) {
    const unsigned G = gridDim.x * gridDim.y * gridDim.z;
    unsigned sum, cnt, mine, sp = 0u;
    for (;;) {
        sum = 0u; cnt = 0u; mine = 0u;
#pragma unroll
        for (unsigned j = 0; j < 16; ++j) { const unsigned c = xb_ld(&bar[XB_XCNT(j)]); sum += c; cnt += (c > 0u) ? 1u : 0u; mine = (j == x) ? c : mine; }
        if (sum == G) break;
        __builtin_amdgcn_s_sleep(1);
        if ((++sp & 255u) == 0u) { if (xb_ld(&bar[XB_TMO])) break; if (sp > XB_SPIN_CAP) { atomicAdd(&bar[XB_TMO], 1u); break; } }
    }
    nloc = mine > 0u ? mine : 1u; nx = cnt > 0u ? cnt : 1u;
}

__device__ __forceinline__ void xcd_barrier(const XcdBarrier& b) {
    asm volatile("s_waitcnt vmcnt(0)" ::: "memory");
    __syncthreads();
    if (TID_OF(b.w0) == 0) {
        unsigned* bar = b.bar; unsigned bx = b.x; asm volatile("" : "+s"(bar), "+s"(bx));
        __builtin_amdgcn_s_waitcnt(0);
        unsigned nloc = b.st[0], nx = b.st[1];
        if (nloc == 0u) { xcd_barrier_complete(bar, bx, nloc, nx); b.st[0] = nloc; b.st[1] = nx; }
        const unsigned old = xb_add(&bar[XB_XSUB(bx)], 1u);
        const unsigned gen = old / nloc;
        if (old + 1u == (gen + 1u) * nloc) {
            __builtin_amdgcn_fence(__ATOMIC_RELEASE, "agent");
            asm volatile("s_waitcnt vmcnt(0)" ::: "memory");
            const unsigned og = xb_add(&bar[XB_TOP], 1u);
            const unsigned tg = og / nx;
            if (og + 1u == (tg + 1u) * nx) xb_add(&bar[XB_TOPGEN], 1u);
            else XB_SPIN(xb_ld(&bar[XB_TOPGEN]) == tg, bar);
            __builtin_amdgcn_fence(__ATOMIC_ACQUIRE, "agent");
            xb_add(&bar[XB_XGEN(bx)], 1u);
            asm volatile("s_waitcnt vmcnt(0)" ::: "memory");
        } else {
            XB_SPIN(xb_ld(&bar[XB_XGEN(bx)]) == gen, bar);
            __builtin_amdgcn_fence(__ATOMIC_ACQUIRE, "agent");
            asm volatile("s_waitcnt vmcnt(0)" ::: "memory");
        }
    }
    __syncthreads();
}

#ifndef MK_SPLIT
#define MK_SPLIT 0
#endif
__device__ __forceinline__ unsigned char* opq(unsigned char* p) { asm volatile("" : "+s"(p)); return p; }
__global__ void __launch_bounds__(512, 2) fwd(Args a) {
    extern __shared__ __attribute__((aligned(16))) unsigned char lds_raw[];
    LAS unsigned char* lds = (LAS unsigned char*)lds_raw;
    cg::grid_group grid = cg::this_grid();
    volatile LAS unsigned* misc = (volatile LAS unsigned*)(lds + 139264);
    if (a.ph_hi == 0x7fffffff) grid.sync();
    const int w0 = __builtin_amdgcn_readfirstlane((int)threadIdx.x >> 6);
    if (TID_OF(w0) < 16) misc[TID_OF(w0)] = 0u;
    __syncthreads();
    const XcdBarrier bar = xcd_barrier_post((unsigned*)(a.ws + WS_BAR), misc, w0);
    const int G = gridDim.x, c = blockIdx.x;
#if MK_SPLIT
    const int lo = a.ph_lo, hi = a.ph_hi;
#define IN(k) (lo <= (k) && (k) < hi)
#define SEAM(k) do { if (IN(k) && IN((k) + 1)) grid.sync(); } while (0)
#else
#define IN(k) true
#define SEAM(k) xcd_barrier(bar)
#endif
#ifndef DIS_P0
    if (IN(0)) p0_phase(lds, a, w0);
#endif
    SEAM(0);
#pragma unroll 1
    for (int L = 0; L < DEPTH; ++L) {
        const int ph = 1 + 4 * L;
        if (IN(ph)) {
            int cp_ = c; asm volatile("" : "+s"(cp_)); const bool pp_first = ((cp_ >> 3) & 1) != 0;
#pragma unroll 1
            for (int step = 0; step < 2; ++step) {
                if ((step == 0) != pp_first) {
                    unsigned char* ws = ka_ws();
                    pg8::Gemm g{(const bf16_t*)(ws + WS_XB0), (const bf16_t*)(ws + WS_WIN) + (size_t)L * INW * DM, MR, INW, DM}; int c1_ = c; asm volatile("" : "+s"(c1_)); pg8::StaticOrder S; S.init(MR, INW, G, c1_);
                    EpiIn E{L};
                    pg8::gemm_phase<EpiIn, pg8::StaticOrder, true, true>(lds, g, S, E, w0);
                } else {
                    unsigned char* ws = ka_ws();
                    pg8::Gemm g{(const bf16_t*)(ws + WS_PB) + (size_t)L * MR * PLE, (const bf16_t*)(ws + WS_WPP) + (size_t)L * DM * PLE, MR, DM, PLE};
                    const int nu = (MR / 256) * (INW / 256); int c2_ = c; asm volatile("" : "+s"(c2_)); FillOrder S; S.init(MR, DM, G, c2_, nu % G);
                    EpiPP E{0};
                    pg8::gemm_phase<EpiPP, FillOrder, true, true>(lds, g, S, E, w0);
                    if (c >= nu % G) { int t_ = TID_OF(w0); asm volatile("" : "+v"(t_)); copy_cache_window(L, (c - nu % G) * 512 + t_, (G - nu % G) * 512); }
                }
            }
        }
        SEAM(ph);
        if (IN(ph + 1)) {
#ifndef DIS_P2
            unsigned char* ws = ka_ws();
            p2_phase(lds, L, w0);
#endif
        }
        SEAM(ph + 1);
        if (IN(ph + 2)) {
#ifndef DIS_P3A
            unsigned char* ws = ka_ws();
            pg8::Gemm g{(const bf16_t*)(ws + WS_MIX), (const bf16_t*)(ws + WS_WOUT) + (size_t)L * DM * DM, NPR, DM, DM}; pg8::StaticOrder S; S.init(NPR, DM, G, c);
            EpiOut E{0};
            int cb_ = c; asm volatile("" : "+s"(cb_)); const bool small_first = ((cb_ >> 3) & 1) == 0;
#pragma unroll 1
            for (int step = 0; step < 2; ++step) {
                if ((step == 0) == small_first) small_gemm<EpiOut>(lds, g.A + (size_t)NPR * DM, g.Bt, E, w0);
                else pg8::gemm_phase<EpiOut, pg8::StaticOrder, true, true>(lds, g, S, E, w0);
            }
#endif
        }
        SEAM(ph + 2);
        if (IN(ph + 3)) {
#ifndef DIS_P3B
            unsigned char* ws = ka_ws();
            pg8::Gemm g{(const bf16_t*)(ws + WS_XB1), (const bf16_t*)(ws + WS_WPG) + (size_t)L * DM * DM, NPR, DM, DM}; pg8::StaticOrder S; S.init(NPR, DM, G, c);
            EpiGate E{0};
            int cb_ = c; asm volatile("" : "+s"(cb_)); const bool small_first = ((cb_ >> 3) & 1) == 0;
#pragma unroll 1
            for (int step = 0; step < 2; ++step) {
                if ((step == 0) == small_first) small_gemm<EpiGate>(lds, g.A + (size_t)NPR * DM, g.Bt, E, w0);
                else pg8::gemm_phase<EpiGate, pg8::StaticOrder, true, true>(lds, g, S, E, w0);
            }
#endif
        }
        SEAM(ph + 3);
    }
    if (IN(17)) final_phase(w0);
#undef IN
#undef SEAM
}

extern "C" void kernel_launch(void* const* d_in, const int* in_sizes, int n_in, void* d_out, int out_size, void* d_ws, size_t ws_size, hipStream_t stream) {
    static int grid = 0;
    if (grid == 0) {
        if (n_in != 15 || (size_t)out_size != O_END || ws_size < WS_END) { fprintf(stderr, "kernel_launch: unexpected shapes (n_in %d out %d ws %zu)\n", n_in, out_size, ws_size); grid = -1; return; }
        int dev = 0, cus = 0, per = 0;
        if (hipGetDevice(&dev) != hipSuccess || hipDeviceGetAttribute(&cus, hipDeviceAttributeMultiprocessorCount, dev) != hipSuccess) { grid = -1; return; }
        if (hipFuncSetAttribute((const void*)fwd, hipFuncAttributeMaxDynamicSharedMemorySize, LDS_BYTES) != hipSuccess) { fprintf(stderr, "kernel_launch: hipFuncSetAttribute failed\n"); grid = -1; return; }
        if (hipOccupancyMaxActiveBlocksPerMultiprocessor(&per, (const void*)fwd, 512, LDS_BYTES) != hipSuccess || per < 1) { fprintf(stderr, "kernel_launch: occupancy query %d\n", per); per = 1; }
        (void)hipGetLastError();
        grid = cus;
        fprintf(stderr, "kernel_launch: grid %d (cus %d x per_cu %d), ws %zu\n", grid, cus, per, ws_size);
    }
    if (grid < 0) return;
    if (hipMemsetAsync((char*)d_ws + WS_BAR, 0, 16384, stream) != hipSuccess) { fprintf(stderr, "kernel_launch: memset failed\n"); return; }
    Args a{};
    for (int i = 0; i < 15; ++i) a.in[i] = (const float*)d_in[i];
    a.out = (float*)d_out; a.ws = (unsigned char*)d_ws;
#if MK_SPLIT
    for (int ph = 0; ph < 18; ++ph) { a.ph_lo = ph; a.ph_hi = ph + 1; hipLaunchKernelGGL(fwd, dim3(grid), dim3(512), LDS_BYTES, stream, a); }
#else
    a.ph_lo = 0; a.ph_hi = 18;
    void* args[] = {&a};
    const hipError_t e = hipLaunchCooperativeKernel((const void*)fwd, dim3(grid), dim3(512), args, LDS_BYTES, stream);
    if (e != hipSuccess) fprintf(stderr, "kernel_launch: cooperative launch failed: %s (grid %d)\n", hipGetErrorString(e), grid);
#endif
}
```

```cpp
#include <hip/hip_runtime.h>
#include <hip/hip_cooperative_groups.h>
#include <cstdio>
#include <cstdint>
namespace cg = cooperative_groups;
__device__ __forceinline__ int lane_id() { int l; asm volatile("v_mbcnt_lo_u32_b32 %0, -1, 0\n\tv_mbcnt_hi_u32_b32 %0, -1, %0" : "=v"(l)); return l; }
#define TID_OF(w0) ((w0) * 64 + lane_id())
namespace pg8 {
#define PG8_LAS __attribute__((address_space(3)))
typedef unsigned short bf16_t;
typedef short bf16x8 __attribute__((ext_vector_type(8)));
typedef float f32x4 __attribute__((ext_vector_type(4)));
typedef unsigned u32x4 __attribute__((ext_vector_type(4)));
constexpr int BM = 256, BK = 64, HALF = 128, HTB = HALF * BK * 2  , STAGE_BYTES = 8 * HTB, NXCD = 8, WGM = 8;

__host__ __device__ __forceinline__ int lds_byte(int r, int c) { const int st = (r >> 4) * 2 + (c >> 5), rr = r & 15, cc = c & 31, ob = rr * 64 + cc * 2; return st * 1024 + (ob ^ (((ob >> 9) & 1) << 5)); }
__host__ __device__ __forceinline__ void stage_rc(int b, int& R, int& C) { const int st = b / 1024, sb = b % 1024, swz = sb ^ (((sb >> 9) & 1) << 5); R = (st >> 1) * 16 + swz / 64; C = (st & 1) * 32 + (swz % 64) / 2; }
__host__ __device__ __forceinline__ int perm32(int rho) { const int n = rho >> 4, i = rho & 15; return 8 * (i >> 2) + 4 * n + (i & 3); }

struct Unit { int pm, pn; };
struct Gemm { const bf16_t* A; const bf16_t* Bt; int M, N, K; };

struct StaticOrder {
    int nM, nN, nwg, G, c;
    __host__ __device__ void init(int M, int N, int G_, int c_) { nM = M / BM; nN = N / BM; nwg = nM * nN; G = G_; c = c_; }
    __host__ __device__ bool next(int i, Unit& u) const {
        const long L = (long)i * G + c; if (L >= nwg) return false;
        int wgid = (int)L; { const int q = nwg / NXCD, r = nwg % NXCD, xcd = wgid % NXCD, off = wgid / NXCD; wgid = (xcd < r ? xcd * (q + 1) : r * (q + 1) + (xcd - r) * q) + off; }
        const int nig = WGM * nN, gid = wgid / nig, fm = gid * WGM, gsz = (nM - fm) < WGM ? (nM - fm) : WGM;
        u.pm = fm + ((wgid % nig) % gsz); u.pn = (wgid % nig) / gsz; return true;
    }
    __device__ __forceinline__ void a_ready(const Unit&) const {}
    __device__ __forceinline__ void done(const Unit&) const {}
};

__device__ __forceinline__ unsigned cvt_pk_bf16(float lo, float hi) { unsigned r; asm volatile("v_cvt_pk_bf16_f32 %0, %1, %2" : "=v"(r) : "v"(lo), "v"(hi)); return r; }
typedef float f32x2 __attribute__((ext_vector_type(2)));
template <class Epi, class Sched, bool ALIGN_EPI = false, bool SP2 = false>
__device__ __forceinline__ void gemm_phase(PG8_LAS unsigned char* lds, const Gemm g, const Sched& S, const Epi& E, const int w0) {
    int tid_ = TID_OF(w0); asm volatile("" : "+v"(tid_));
    const int tid = tid_, wid = __builtin_amdgcn_readfirstlane(tid >> 6), lane = tid & 63, wr = wid >> 2, wc = wid & 3, fr = lane & 15, fq = lane >> 4;
    const int K = g.K, nt = K / BK;
    unsigned voffA[2], voffB[2];
#pragma unroll
    for (int i = 0; i < 2; ++i) { int R, C; stage_rc(tid * 16 + i * 8192, R, C); const int Rb = Epi::PERM ? ((R & ~31) + perm32(R & 31)) : R;
        voffA[i] = (unsigned)(R * K + C) * 2u; voffB[i] = (unsigned)(Rb * K + C) * 2u; }
    const size_t kstep = (size_t)(BK * 2);
    const size_t hstep = (size_t)HALF * K * 2;
    const size_t tstep = 2 * hstep;
    const unsigned ldsw = (unsigned)wid * 1024u;
    const int aoff = lds_byte(wr * 64 + fr, fq * 8), boff = lds_byte(wc * 32 + fr, fq * 8);
#define PG8_SA(b, h) (((b) * 2 + (h)) * HTB)
#define PG8_SB(b, h) ((4 + (b) * 2 + (h)) * HTB)
#define PG8_STAGE(bufoff, gbase, voff) do { _Pragma("unroll") for (int _i = 0; _i < 2; ++_i) \
        __builtin_amdgcn_global_load_lds((const unsigned*)((const char*)(gbase) + (voff)[_i]), (PG8_LAS unsigned*)(lds + (bufoff) + ldsw + _i * 8192), 16, 0, 0); } while (0)
#define PG8_LDA(dst, b, h) do { _Pragma("unroll") for (int m = 0; m < 4; ++m) _Pragma("unroll") for (int k = 0; k < 2; ++k) dst[m][k] = *(const PG8_LAS bf16x8*)(lds + PG8_SA(b, h) + aoff + m * 2048 + k * 1024); } while (0)
#define PG8_LDB(dst, b, h) do { _Pragma("unroll") for (int n = 0; n < 2; ++n) _Pragma("unroll") for (int k = 0; k < 2; ++k) dst[n][k] = *(const PG8_LAS bf16x8*)(lds + PG8_SB(b, h) + boff + n * 2048 + k * 1024); } while (0)
#define PG8_MMA(ai, bj, At, Bt) do { __builtin_amdgcn_s_setprio(1); _Pragma("unroll") for (int m = 0; m < 4; ++m) _Pragma("unroll") for (int n = 0; n < 2; ++n) _Pragma("unroll") for (int k = 0; k < 2; ++k) \
        acc[ai][bj][m][n] = __builtin_amdgcn_mfma_f32_16x16x32_bf16(Bt[n][k], At[m][k], acc[ai][bj][m][n], 0, 0, 0); __builtin_amdgcn_s_setprio(0); } while (0)
#define PG8_WAIT_V(n) asm volatile("s_waitcnt vmcnt(" #n ")" ::: "memory")
#define PG8_WAIT_L(n) asm volatile("s_waitcnt lgkmcnt(" #n ")" ::: "memory")
#define PG8_BAR __builtin_amdgcn_s_barrier()
#define PG8_SCHED __builtin_amdgcn_sched_barrier(0)
    Unit cur, nxt; int ui = 0;
    if (!S.next(0, cur)) return;
    f32x4 acc[2][2][4][2];
#pragma unroll
    for (int a = 0; a < 2; ++a)
#pragma unroll
        for (int b = 0; b < 2; ++b)
#pragma unroll
            for (int m = 0; m < 4; ++m)
#pragma unroll
                for (int n = 0; n < 2; ++n) acc[a][b][m][n] = (f32x4){0.f, 0.f, 0.f, 0.f};
    bf16x8 At[4][2], B0[2][2], B1[2][2];
    const char* cA = (const char*)g.A + (size_t)cur.pm * tstep; const char* cB = (const char*)g.Bt + (size_t)cur.pn * tstep;
    S.a_ready(cur);
    if constexpr (SP2) {
        PG8_STAGE(PG8_SB(0, 0), cB, voffB); PG8_STAGE(PG8_SB(0, 1), cB + hstep, voffB); PG8_STAGE(PG8_SA(0, 0), cA, voffA); PG8_STAGE(PG8_SA(0, 1), cA + hstep, voffA);
        if (wr == 1) PG8_BAR;
        PG8_WAIT_V(2); PG8_BAR;
        PG8_STAGE(PG8_SB(1, 0), cB + kstep, voffB); PG8_STAGE(PG8_SA(1, 0), cA + kstep, voffA); PG8_STAGE(PG8_SB(1, 1), cB + hstep + kstep, voffB);
        PG8_WAIT_V(6); PG8_BAR;
    } else {
        PG8_STAGE(PG8_SB(0, 0), cB, voffB); PG8_STAGE(PG8_SA(0, 0), cA, voffA); PG8_STAGE(PG8_SB(0, 1), cB + hstep, voffB); PG8_STAGE(PG8_SA(0, 1), cA + hstep, voffA);
        if (wr == 1) PG8_BAR;
        PG8_WAIT_V(4); PG8_BAR;
        PG8_STAGE(PG8_SB(1, 0), cB + kstep, voffB); PG8_STAGE(PG8_SA(1, 0), cA + kstep, voffA); PG8_STAGE(PG8_SB(1, 1), cB + hstep + kstep, voffB);
        PG8_WAIT_V(6); PG8_BAR;
    }
    for (;;) {
        const bool has_next = S.next(ui + 1, nxt);
        const char* nA = has_next ? (const char*)g.A + (size_t)nxt.pm * tstep : cA; const char* nB = has_next ? (const char*)g.Bt + (size_t)nxt.pn * tstep : cB;
#pragma unroll 1
        for (int t = 0; t < nt; t += 2) {
            const bool last = (t == nt - 2);
            const char* a1 = cA + (size_t)(t + 1) * kstep;
            const char* a2 = last ? nA : cA + (size_t)(t + 2) * kstep; const char* b2 = last ? nB : cB + (size_t)(t + 2) * kstep;
            const char* a3 = a2 + kstep; const char* b3 = b2 + kstep;
            if (last && has_next) S.a_ready(nxt);
            if constexpr (SP2) {
            PG8_LDB(B0, 0, 0); PG8_LDB(B1, 0, 1); PG8_SCHED; PG8_LDA(At, 0, 0); PG8_STAGE(PG8_SA(1, 1), a1 + hstep, voffA);
            PG8_WAIT_V(8); PG8_WAIT_L(0); PG8_BAR; PG8_MMA(0, 0, At, B0); PG8_MMA(0, 1, At, B1); PG8_BAR; PG8_SCHED;
            PG8_LDA(At, 0, 1); PG8_STAGE(PG8_SB(0, 0), b2, voffB); PG8_STAGE(PG8_SB(0, 1), b2 + hstep, voffB); PG8_STAGE(PG8_SA(0, 0), a2, voffA);
            PG8_WAIT_V(8); PG8_WAIT_L(0); PG8_BAR; PG8_MMA(1, 0, At, B0); PG8_MMA(1, 1, At, B1); PG8_BAR; PG8_SCHED;
            PG8_LDB(B0, 1, 0); PG8_LDB(B1, 1, 1); PG8_SCHED; PG8_LDA(At, 1, 0); PG8_STAGE(PG8_SA(0, 1), a2 + hstep, voffA);
            PG8_WAIT_V(8); PG8_WAIT_L(0); PG8_BAR; PG8_MMA(0, 0, At, B0); PG8_MMA(0, 1, At, B1); PG8_BAR; PG8_SCHED;
            PG8_LDA(At, 1, 1); PG8_STAGE(PG8_SB(1, 0), b3, voffB); PG8_STAGE(PG8_SB(1, 1), b3 + hstep, voffB); PG8_STAGE(PG8_SA(1, 0), a3, voffA);
            PG8_WAIT_V(8); PG8_WAIT_L(0); PG8_BAR; PG8_MMA(1, 0, At, B0); PG8_MMA(1, 1, At, B1); PG8_BAR; PG8_SCHED;
            } else {
            PG8_LDB(B0, 0, 0); PG8_SCHED; PG8_LDA(At, 0, 0); PG8_STAGE(PG8_SA(1, 1), a1 + hstep, voffA);
            PG8_WAIT_L(8); PG8_BAR; PG8_WAIT_L(0); PG8_MMA(0, 0, At, B0); PG8_BAR; PG8_SCHED;
            PG8_LDB(B1, 0, 1); PG8_STAGE(PG8_SB(0, 0), b2, voffB);
            PG8_BAR; PG8_WAIT_L(0); PG8_MMA(0, 1, At, B1); PG8_BAR;
            PG8_LDA(At, 0, 1); PG8_STAGE(PG8_SA(0, 0), a2, voffA);
            PG8_BAR; PG8_WAIT_L(0); PG8_MMA(1, 0, At, B0); PG8_BAR; PG8_SCHED;
            PG8_STAGE(PG8_SB(0, 1), b2 + hstep, voffB);
            PG8_WAIT_V(6); PG8_BAR; PG8_MMA(1, 1, At, B1); PG8_BAR;
            PG8_LDB(B0, 1, 0); PG8_SCHED; PG8_LDA(At, 1, 0); PG8_STAGE(PG8_SA(0, 1), a2 + hstep, voffA);
            PG8_WAIT_L(8); PG8_BAR; PG8_WAIT_L(0); PG8_MMA(0, 0, At, B0); PG8_BAR; PG8_SCHED;
            PG8_LDB(B1, 1, 1); PG8_STAGE(PG8_SB(1, 0), b3, voffB);
            PG8_BAR; PG8_WAIT_L(0); PG8_MMA(0, 1, At, B1); PG8_BAR;
            PG8_LDA(At, 1, 1); PG8_STAGE(PG8_SA(1, 0), a3, voffA);
            PG8_BAR; PG8_WAIT_L(0); PG8_MMA(1, 0, At, B0); PG8_BAR; PG8_SCHED;
            PG8_STAGE(PG8_SB(1, 1), b3 + hstep, voffB);
            PG8_WAIT_V(6); PG8_BAR; PG8_MMA(1, 1, At, B1); PG8_BAR;
            }
        }
        if constexpr (ALIGN_EPI) { if (wr == 0) PG8_BAR; }
        if constexpr (!Epi::AFTER_DRAIN) { E(acc, cur, wr, wc, fr, fq); S.done(cur); }
        if (!has_next) break;
#pragma unroll
        for (int a = 0; a < 2; ++a)
#pragma unroll
            for (int b = 0; b < 2; ++b)
#pragma unroll
                for (int m = 0; m < 4; ++m)
#pragma unroll
                    for (int n = 0; n < 2; ++n) acc[a][b][m][n] = (f32x4){0.f, 0.f, 0.f, 0.f};
        cur = nxt; cA = nA; cB = nB; ++ui;
        if constexpr (ALIGN_EPI) { if (wr == 1) PG8_BAR; }
    }
    PG8_WAIT_V(0);
    if constexpr (!ALIGN_EPI) { if (wr == 0) PG8_BAR; }
    PG8_BAR;
    if constexpr (Epi::AFTER_DRAIN) { E.fused(acc, cur, wr, wc, fr, fq, lds, wid, lane); S.done(cur); }
#undef PG8_SA
#undef PG8_SB
#undef PG8_STAGE
#undef PG8_LDA
#undef PG8_LDB
#undef PG8_MMA
#undef PG8_WAIT_V
#undef PG8_WAIT_L
#undef PG8_BAR
#undef PG8_SCHED
}
}

#define GAS __attribute__((address_space(1)))
#define LAS __attribute__((address_space(3)))
using pg8::bf16_t; using pg8::bf16x8; using pg8::f32x4; using pg8::u32x4;
typedef unsigned u32x2 __attribute__((ext_vector_type(2)));
typedef float f32x16 __attribute__((ext_vector_type(16)));
constexpr int DM = 1024, NPR = 16384, NSR = 512, MR = NPR + NSR, DEPTH = 4, INW = 3328, PLE = 256;
constexpr float EPS = 1e-6f, LOG2E = 1.4426950408889634f, QS = 0.125f * 1.4426950408889634f;
constexpr size_t O_NKP = 17301504, O_NVP = 17825792, O_NCP = 18350080, O_NKS = 18382848, O_NVS = 26771456, O_NCS = 35160064, O_END = 35684352;
constexpr size_t MiB = 1u << 20;
constexpr size_t WS_SSP = 0  , WS_TAB = 253 * MiB  , WS_WIN = 2 * MiB, WS_WOUT = 28 * MiB, WS_WPG = 36 * MiB, WS_WPP = 44 * MiB, WS_XB0 = 46 * MiB, WS_PB = 79 * MiB, WS_PP = 112 * MiB,
                 WS_MIX = 145 * MiB, WS_Q = 178 * MiB, WS_SGA = WS_Q + 16 * MiB + MiB / 2, WS_XB1 = WS_Q, WS_BGC = 211 * MiB, WS_U = WS_BGC + 16 * MiB + MiB / 2, WS_K = 244 * MiB,
                 WS_V = WS_K + 4 * MiB + MiB / 8, WS_BAR = 254 * MiB  , WS_END = 255 * MiB;
static_assert(WS_V + 4 * MiB + MiB / 8 <= WS_TAB && WS_TAB + 2052 * 64 * 4 <= WS_BAR && (size_t)MR * 16 * 4 <= 2 * MiB && WS_END <= 256 * MiB, "ws map");
constexpr int LDS_BYTES = 147456;
template <class T, class P> __device__ __forceinline__ T gld(P p) { return *(GAS const T*)p; }
template <class T, class P> __device__ __forceinline__ void gst(P p, T v) { *(GAS T*)p = v; }
template <class T, class P> __device__ __forceinline__ void gst_nt(P p, T v) { __builtin_nontemporal_store(v, (GAS T*)p); }
template <class T, class P> __device__ __forceinline__ T gld_nt(P p) { return __builtin_nontemporal_load((GAS const T*)p); }

__device__ __forceinline__ unsigned pk2(float lo, float hi) { return pg8::cvt_pk_bf16(lo, hi); }
__device__ __forceinline__ u32x4 pk8(f32x4 a, f32x4 b) { u32x4 w; w.x = pk2(a[0], a[1]); w.y = pk2(a[2], a[3]); w.z = pk2(b[0], b[1]); w.w = pk2(b[2], b[3]); return w; }
__device__ __forceinline__ u32x2 pk4(f32x4 a) { u32x2 w; w.x = pk2(a[0], a[1]); w.y = pk2(a[2], a[3]); return w; }
__device__ __forceinline__ float bflo(unsigned w) { return __uint_as_float(w << 16); }
__device__ __forceinline__ float bfhi(unsigned w) { return __uint_as_float(w & 0xffff0000u); }
__device__ __forceinline__ float sigm(float x) { return __builtin_amdgcn_rcpf(1.f + __builtin_amdgcn_exp2f(-x * LOG2E)); }
__device__ __forceinline__ f32x4 silu4(f32x4 x) { f32x4 r; for (int i = 0; i < 4; ++i) r[i] = x[i] * sigm(x[i]); return r; }
__device__ __forceinline__ f32x4 sigm4(f32x4 x) { f32x4 r; for (int i = 0; i < 4; ++i) r[i] = sigm(x[i]); return r; }
__device__ __forceinline__ float row_rs(const float* ssp, int row, int fq) {
    const f32x4 v = gld<f32x4>(ssp + (size_t)row * 16 + fq * 4); float s = (v[0] + v[1]) + (v[2] + v[3]);
    s += __shfl_xor(s, 16); s += __shfl_xor(s, 32);
    return __builtin_amdgcn_rsqf(s * (1.f / 1024.f) + EPS);
}


typedef __attribute__((address_space(4))) const unsigned char* kptr_t;
__device__ __forceinline__ unsigned long long ka_u64(int off) { kptr_t p = (kptr_t)__builtin_amdgcn_kernarg_segment_ptr(); asm volatile("" : "+s"(p)); return *(__attribute__((address_space(4))) const unsigned long long*)(p + off); }
__device__ __forceinline__ const float* ka_in(int k) { return (const float*)(GAS const float*)ka_u64(8 * k); }
__device__ __forceinline__ float* ka_out() { return (float*)(GAS float*)ka_u64(120); }
__device__ __forceinline__ unsigned char* ka_ws() { return (unsigned char*)(GAS unsigned char*)ka_u64(128); }

struct EpiIn {
    static constexpr bool PERM = true, AFTER_DRAIN = false;
    int L;
    struct Ld { f32x4 ss, c0, c1, s0, s1; };
    __device__ __forceinline__ void operator()(const f32x4 (&acc)[2][2][4][2], const pg8::Unit& u, int wr, int wc, int fr_, int fq_) const {
        int lane_ = fr_ + 16 * fq_; asm volatile("" : "+v"(lane_)); const int fr = lane_ & 15, fq = lane_ >> 4;
        const int pn = u.pn; unsigned char* ws = ka_ws(); float* out = ka_out();
        const float* ssp = (const float*)(ws + WS_SSP); const float* tab = (const float*)(ws + WS_TAB);
        bf16_t *Q = (bf16_t*)(ws + WS_Q), *K = (bf16_t*)(ws + WS_K), *V = (bf16_t*)(ws + WS_V), *SGA = (bf16_t*)(ws + WS_SGA), *BGC = (bf16_t*)(ws + WS_BGC), *U = (bf16_t*)(ws + WS_U);
        const bool rope = pn < 2 || (pn == 2 && wc < 2);
        const int row0 = u.pm * 256 + wr * 64 + fr, cw = wc * 32 + fq * 8;
        Ld ld[8];
#pragma unroll
        for (int it = 0; it < 10; ++it) {
            if (it < 8) {
                const int row = row0 + (it >> 2) * 128 + (it & 3) * 16;
                ld[it].ss = gld<f32x4>(ssp + (size_t)row * 16 + fq * 4);
                if (rope) { const int pidx = row < NPR ? (row & 2047) : 2048 + (row & 3); const float* tp = tab + (size_t)pidx * 64 + fq * 8;
                    ld[it].c0 = gld<f32x4>(tp); ld[it].c1 = gld<f32x4>(tp + 4); ld[it].s0 = gld<f32x4>(tp + 32); ld[it].s1 = gld<f32x4>(tp + 36); }
            }
            if (it >= 2) {
                const int k = it - 2, ai = k >> 2, m = k & 3, row = row0 + ai * 128 + m * 16;
                float sq = (ld[k].ss[0] + ld[k].ss[1]) + (ld[k].ss[2] + ld[k].ss[3]); sq += __shfl_xor(sq, 16); sq += __shfl_xor(sq, 32);
                const float rs = __builtin_amdgcn_rsqf(sq * (1.f / 1024.f) + EPS);
                const f32x4 a0 = acc[ai][0][m][0] * rs, a1 = acc[ai][0][m][1] * rs, b0 = acc[ai][1][m][0] * rs, b1 = acc[ai][1][m][1] * rs;
                if (rope) {
                    const f32x4 c0 = ld[k].c0, c1 = ld[k].c1, s0 = ld[k].s0, s1 = ld[k].s1;
                    f32x4 o1a = a0 * c0 - b0 * s0, o1b = a1 * c1 - b1 * s1, o2a = b0 * c0 + a0 * s0, o2b = b1 * c1 + a1 * s1;
                    if (pn < 2) {
                        o1a *= QS; o1b *= QS; o2a *= QS; o2b *= QS;
                        bf16_t* q = Q + (size_t)row * 512 + (4 * pn + wc) * 64 + fq * 8;
                        gst<u32x4>(q, pk8(o1a, o1b)); gst<u32x4>(q + 32, pk8(o2a, o2b));
                    } else {
                        bf16_t* kk = K + (size_t)row * 128 + wc * 64 + fq * 8;
                        gst<u32x4>(kk, pk8(o1a, o1b)); gst<u32x4>(kk + 32, pk8(o2a, o2b));
                        const bool smp = row >= NPR; const bool wr_out = smp || (row & 2047) >= 1920;
                        const size_t kofs = smp ? O_NKS + ((size_t)(L * 128 + ((row - NPR) >> 2)) * 128 + 124 + (row & 3)) * 128 : O_NKP + ((size_t)(L * 8 + (row >> 11)) * 128 + ((row & 2047) - 1920)) * 128;
                        if (wr_out) { float* ko = out + kofs + wc * 64 + fq * 8; gst<f32x4>(ko, o1a); gst<f32x4>(ko + 4, o1b); gst<f32x4>(ko + 32, o2a); gst<f32x4>(ko + 36, o2b); }
                    }
                } else if (pn == 2) {
                    bf16_t* v = V + (size_t)row * 128 + (wc - 2) * 32 + fq * 8;
                    gst<u32x4>(v, pk8(a0, a1)); gst<u32x4>(v + 64, pk8(b0, b1));
                    const bool smp = row >= NPR; const bool wr_out = smp || (row & 2047) >= 1920;
                    const size_t vofs = smp ? O_NVS + ((size_t)(L * 128 + ((row - NPR) >> 2)) * 128 + 124 + (row & 3)) * 128 : O_NVP + ((size_t)(L * 8 + (row >> 11)) * 128 + ((row & 2047) - 1920)) * 128;
                    if (wr_out) { float* vo = out + vofs + (wc - 2) * 32 + fq * 8; gst<f32x4>(vo, a0); gst<f32x4>(vo + 4, a1); gst<f32x4>(vo + 64, b0); gst<f32x4>(vo + 68, b1); }
                } else if (pn < 5) {
                    bf16_t* p = SGA + (size_t)row * 512 + (pn - 3) * 256 + cw;
                    gst<u32x4>(p, pk8(silu4(a0), silu4(a1))); gst<u32x4>(p + 128, pk8(silu4(b0), silu4(b1)));
                } else if (pn < 9) {
                    bf16_t* p = BGC + (size_t)row * 512 + (pn - 5) * 128 + cw;
                    gst<u32x4>(p, pk8(a0 * silu4(b0), a1 * silu4(b1)));
                } else {
                    const f32x4 u0 = a0 * b0, u1 = a1 * b1; const int c = (pn - 9) * 128 + cw;
                    gst<u32x4>(U + (size_t)row * 512 + c, pk8(u0, u1));
                    const bool smp = row >= NPR; const bool wr_out = smp ? (row & 3) >= 2 : (row & 2047) >= 2046;
                    const size_t uofs = smp ? O_NCS + ((size_t)(L * 128 + ((row - NPR) >> 2)) * 2 + ((row & 3) - 2)) * 512 : O_NCP + ((size_t)(L * 8 + (row >> 11)) * 2 + ((row & 2047) - 2046)) * 512;
                    if (wr_out) { float* uo = out + uofs + c; gst<f32x4>(uo, u0); gst<f32x4>(uo + 4, u1); }
                }
            }
        }
    }
};
struct EpiPP {
    static constexpr bool PERM = true, AFTER_DRAIN = false;
    int dummy;
    __device__ __forceinline__ void operator()(const f32x4 (&acc)[2][2][4][2], const pg8::Unit& u, int wr, int wc, int fr_, int fq_) const {
        int lane_ = fr_ + 16 * fq_; asm volatile("" : "+v"(lane_)); const int fr = lane_ & 15, fq = lane_ >> 4;
        bf16_t* O = (bf16_t*)(ka_ws() + WS_PP);
#pragma unroll
        for (int ai = 0; ai < 2; ++ai)
#pragma unroll
            for (int m = 0; m < 4; ++m) {
                bf16_t* p = O + (size_t)(u.pm * 256 + ai * 128 + wr * 64 + m * 16 + fr) * DM + u.pn * 256 + wc * 32 + fq * 8;
                *(u32x4*)p = pk8(acc[ai][0][m][0], acc[ai][0][m][1]); gst<u32x4>(p + 128, pk8(acc[ai][1][m][0], acc[ai][1][m][1]));
            }
    }
};
__device__ __forceinline__ f32x4 bf4(u32x2 w) { return (f32x4){bflo(w.x), bfhi(w.x), bflo(w.y), bfhi(w.y)}; }
struct EpiOut {
    static constexpr bool PERM = true, AFTER_DRAIN = false;
    int dummy;
    __device__ __forceinline__ void operator()(const f32x4 (&acc)[2][2][4][2], const pg8::Unit& u, int wr, int wc, int fr_, int fq_) const {
        int lane_ = fr_ + 16 * fq_; asm volatile("" : "+v"(lane_)); const int fr = lane_ & 15, fq = lane_ >> 4;
        unsigned char* ws = ka_ws(); const bf16_t* X0 = (const bf16_t*)(ws + WS_XB0); bf16_t* X1 = (bf16_t*)(ws + WS_XB1);
        const int row0 = u.pm * 256 + wr * 64 + fr, col0 = u.pn * 256 + wc * 32 + fq * 8;
        u32x4 xr[8][2];
#pragma unroll
        for (int it = 0; it < 10; ++it) {
            if (it < 8) { const size_t off = (size_t)(row0 + (it >> 2) * 128 + (it & 3) * 16) * DM + col0;
#pragma unroll
                for (int bj = 0; bj < 2; ++bj) xr[it][bj] = gld<u32x4>(X0 + off + bj * 128); }
            if (it >= 2) { const int k = it - 2, ai = k >> 2, m = k & 3; const size_t off = (size_t)(row0 + ai * 128 + m * 16) * DM + col0;
#pragma unroll
                for (int bj = 0; bj < 2; ++bj) { const u32x4 w = xr[k][bj];
                    gst<u32x4>(X1 + off + bj * 128, pk8(bf4((u32x2){w.x, w.y}) + acc[ai][bj][m][0], bf4((u32x2){w.z, w.w}) + acc[ai][bj][m][1])); } }
        }
    }
    __device__ __forceinline__ void small(f32x4 acc, int row, int col, int chunk) const {
        unsigned char* ws = ka_ws(); const bf16_t* X0 = (const bf16_t*)(ws + WS_XB0); bf16_t* X1 = (bf16_t*)(ws + WS_XB1);
        gst<u32x2>(X1 + (size_t)row * DM + col, pk4(bf4(gld<u32x2>(X0 + (size_t)row * DM + col)) + acc));
    }
};
struct EpiGate {
    static constexpr bool PERM = true, AFTER_DRAIN = false;
    int dummy;
    __device__ __forceinline__ void operator()(const f32x4 (&acc)[2][2][4][2], const pg8::Unit& u, int wr, int wc, int fr_, int fq_) const {
        int lane_ = fr_ + 16 * fq_; asm volatile("" : "+v"(lane_)); const int fr = lane_ & 15, fq = lane_ >> 4;
        unsigned char* ws = ka_ws(); const bf16_t* X1 = (const bf16_t*)(ws + WS_XB1); bf16_t* X0 = (bf16_t*)(ws + WS_XB0); const bf16_t* PP = (const bf16_t*)(ws + WS_PP); float* ssp = (float*)(ws + WS_SSP);
        const int row0 = u.pm * 256 + wr * 64 + fr, col0 = u.pn * 256 + wc * 32 + fq * 8;
        u32x4 xr[8][2], pr[8][2];
#pragma unroll
        for (int it = 0; it < 10; ++it) {
            if (it < 8) { const size_t off = (size_t)(row0 + (it >> 2) * 128 + (it & 3) * 16) * DM + col0;
#pragma unroll
                for (int bj = 0; bj < 2; ++bj) { xr[it][bj] = gld<u32x4>(X1 + off + bj * 128); pr[it][bj] = gld<u32x4>(PP + off + bj * 128); } }
            if (it >= 2) { const int k = it - 2, ai = k >> 2, m = k & 3, row = row0 + ai * 128 + m * 16; const size_t off = (size_t)row * DM + col0; float sq = 0.f;
#pragma unroll
                for (int bj = 0; bj < 2; ++bj) { const u32x4 xw = xr[k][bj], pw = pr[k][bj];
                    const u32x4 w = pk8(bf4((u32x2){xw.x, xw.y}) + sigm4(acc[ai][bj][m][0]) * bf4((u32x2){pw.x, pw.y}), bf4((u32x2){xw.z, xw.w}) + sigm4(acc[ai][bj][m][1]) * bf4((u32x2){pw.z, pw.w}));
                    gst<u32x4>(X0 + off + bj * 128, w);
                    const f32x4 y0 = bf4((u32x2){w.x, w.y}), y1 = bf4((u32x2){w.z, w.w});
                    sq += ((y0[0] * y0[0] + y0[1] * y0[1]) + (y0[2] * y0[2] + y0[3] * y0[3])) + ((y1[0] * y1[0] + y1[1] * y1[1]) + (y1[2] * y1[2] + y1[3] * y1[3])); }
                sq += __shfl_xor(sq, 16); sq += __shfl_xor(sq, 32);
                if (fq == 0) gst<float>(ssp + (size_t)row * 16 + u.pn * 4 + wc, sq); }
        }
    }
    __device__ __forceinline__ void small(f32x4 acc, int row, int col, int chunk) const {
        unsigned char* ws = ka_ws(); const bf16_t* X1 = (const bf16_t*)(ws + WS_XB1); bf16_t* X0 = (bf16_t*)(ws + WS_XB0); const bf16_t* PP = (const bf16_t*)(ws + WS_PP); float* ssp = (float*)(ws + WS_SSP);
        const u32x2 w = pk4(bf4(gld<u32x2>(X1 + (size_t)row * DM + col)) + sigm4(acc) * bf4(gld<u32x2>(PP + (size_t)row * DM + col))); const f32x4 x2 = bf4(w);
        gst<u32x2>(X0 + (size_t)row * DM + col, w);
        float sq = (x2[0] * x2[0] + x2[1] * x2[1]) + (x2[2] * x2[2] + x2[3] * x2[3]);
        sq += __shfl_xor(sq, 1); sq += __shfl_xor(sq, 2); sq += __shfl_xor(sq, 4); sq += __shfl_xor(sq, 8);
        if ((lane_id() & 15) == 0) gst<float>(ssp + (size_t)row * 16 + chunk, sq);
    }
};
struct FillOrder {
    int nN, nwg, c, rem, stride;
    __device__ void init(int M, int N, int G, int c_, int rem_) { nN = N / 256; nwg = (M / 256) * nN; c = c_; rem = rem_; stride = G - rem_; }
    __device__ bool next(int i, pg8::Unit& u) const { if (c < rem) return false; const int idx = (c - rem) + i * stride; if (idx >= nwg) return false; u.pm = idx / nN; u.pn = idx % nN; return true; }
    __device__ __forceinline__ void a_ready(const pg8::Unit&) const {}
    __device__ __forceinline__ void done(const pg8::Unit&) const {}
};

template <class Epi>
__device__ __forceinline__ void small_gemm(LAS unsigned char* lds, const bf16_t* A, const bf16_t* Bt, const Epi& E, const int w0) {
    int tid_ = TID_OF(w0); asm volatile("" : "+v"(tid_));
    const int tid = tid_, lane = tid & 63, wid = __builtin_amdgcn_readfirstlane(tid >> 6), fr = lane & 15, fq = lane >> 4;
    for (int tile = blockIdx.x; tile < 256; tile += gridDim.x) {
        const int rt = tile >> 4, ct = tile & 15, k0 = wid * 128;
        bf16x8 af[2][4], bw[4][4];
#pragma unroll
        for (int i = 0; i < 2; ++i)
#pragma unroll
            for (int ks = 0; ks < 4; ++ks) af[i][ks] = gld<bf16x8>(A + (size_t)(rt * 32 + i * 16 + fr) * DM + k0 + ks * 32 + fq * 8);
#pragma unroll
        for (int j = 0; j < 4; ++j)
#pragma unroll
            for (int ks = 0; ks < 4; ++ks) bw[j][ks] = gld<bf16x8>(Bt + (size_t)(ct * 64 + j * 16 + fr) * DM + k0 + ks * 32 + fq * 8);
        f32x4 acc[2][4];
#pragma unroll
        for (int i = 0; i < 2; ++i)
#pragma unroll
            for (int j = 0; j < 4; ++j) { acc[i][j] = (f32x4){0.f, 0.f, 0.f, 0.f};
#pragma unroll
                for (int ks = 0; ks < 4; ++ks) acc[i][j] = __builtin_amdgcn_mfma_f32_16x16x32_bf16(bw[j][ks], af[i][ks], acc[i][j], 0, 0, 0); }
        __syncthreads();
#pragma unroll
        for (int i = 0; i < 2; ++i)
#pragma unroll
            for (int j = 0; j < 4; ++j) *(LAS f32x4*)(lds + ((wid * 8 + i * 4 + j) * 64 + lane) * 16) = acc[i][j];
        __syncthreads();
        const int row = tid >> 4, c4 = tid & 15, til = (row >> 4) * 4 + (c4 >> 2), l = (row & 15) + 16 * (c4 & 3);
        f32x4 sum = (f32x4){0.f, 0.f, 0.f, 0.f};
#pragma unroll
        for (int w = 0; w < 8; ++w) sum += *(LAS const f32x4*)(lds + ((w * 8 + til) * 64 + l) * 16);
        E.small(sum, NPR + rt * 32 + row, ct * 64 + c4 * 4, ct);
    }
    __syncthreads();
}

constexpr int KSTR = 144, VSTR = 520, VSTR_S = 328;
constexpr int VOFF = 256 * KSTR, SK_OFF = VOFF + 64 * VSTR, SV_OFF = SK_OFF + 160 * KSTR, P2_LDS_END = SV_OFF + 64 * VSTR_S;
constexpr int STG_OFF = P2_LDS_END;
static_assert(STG_OFF + 8 * 2048 <= 131072, "P2 LDS map");
typedef unsigned long long u64;
template <int VS>
__device__ __forceinline__ void attn_qk(LAS const unsigned char* Kl, const bf16x8 (&qf)[4], int kt0, int qi, int kjmin, float sink2, int lane, f32x16 (&s)[5], float& inv_l) {
    asm volatile("" : "+v"(qi), "+v"(lane));
    const int l31 = lane & 31, hi = lane >> 5;
#pragma unroll
    for (int ti = 0; ti < 5; ++ti) {
        f32x16 a = {};
#pragma unroll
        for (int c = 0; c < 4; ++c) { const bf16x8 kf = *(LAS const bf16x8*)(Kl + (32 * (kt0 + ti) + l31) * KSTR + (16 * c + 8 * hi) * 2); a = __builtin_amdgcn_mfma_f32_32x32x16_bf16(kf, qf[c], a, 0, 0, 0); }
        s[ti] = a;
    }
    float mx = sink2;
    const int kj0 = 32 * kt0 + 4 * hi, lo_ = max(qi + 1, kjmin), dA = kj0 - lo_, dB = qi + 128 - kj0;
    if (kjmin > 0) {
#pragma unroll
        for (int ti = 0; ti < 5; ++ti)
#pragma unroll
            for (int r = 0; r < 16; ++r) { const int cc = 32 * ti + (r & 3) + 8 * (r >> 2); const int mm = min(dA + cc, dB - cc);
                const float v = s[ti][r] + __int_as_float((mm >> 31) & (int)0xF149F2CAu); s[ti][r] = v; mx = fmaxf(mx, v); }
    } else {
#pragma unroll
        for (int ti = 0; ti < 5; ++ti)
#pragma unroll
            for (int r = 0; r < 16; ++r) { float v = s[ti][r];
                if (ti == 0 || ti == 4) { const int cc = 32 * ti + (r & 3) + 8 * (r >> 2); const int mm = min(dA + cc, dB - cc); v += __int_as_float((mm >> 31) & (int)0xF149F2CAu); s[ti][r] = v; }
                mx = fmaxf(mx, v); }
    }
    mx = fmaxf(mx, __shfl_xor(mx, 32));
    float l = 0.f;
#pragma unroll
    for (int ti = 0; ti < 5; ++ti)
#pragma unroll
        for (int r = 0; r < 16; ++r) { const float p = __builtin_amdgcn_exp2f(s[ti][r] - mx); s[ti][r] = p; l += p; }
    l += __shfl_xor(l, 32); l += __builtin_amdgcn_exp2f(sink2 - mx);
    inv_l = __builtin_amdgcn_rcpf(l);
}
template <int VS>
__device__ __forceinline__ void attn_pv(LAS const unsigned char* Vl, const f32x16 (&s)[5], int kt0, int lane, f32x16 (&o)[2]) {
    const int l31 = lane & 31, hi = lane >> 5;
    o[0] = (f32x16){}; o[1] = (f32x16){};
#pragma unroll
    for (int ti = 0; ti < 5; ++ti)
#pragma unroll
        for (int c2 = 0; c2 < 2; ++c2) {
            u32x4 pw; pw.x = pk2(s[ti][8 * c2 + 0], s[ti][8 * c2 + 1]); pw.y = pk2(s[ti][8 * c2 + 2], s[ti][8 * c2 + 3]); pw.z = pk2(s[ti][8 * c2 + 4], s[ti][8 * c2 + 5]); pw.w = pk2(s[ti][8 * c2 + 6], s[ti][8 * c2 + 7]);
            const bf16x8 pf = __builtin_bit_cast(bf16x8, pw);
            const int kb = 32 * (kt0 + ti) + 16 * c2 + 4 * hi;
#pragma unroll
            for (int dh = 0; dh < 2; ++dh) {
                const u64 lo = *(LAS const u64*)(Vl + (32 * dh + l31) * VS + kb * 2), hi8 = *(LAS const u64*)(Vl + (32 * dh + l31) * VS + (kb + 8) * 2);
                u32x4 vw; vw.x = (unsigned)lo; vw.y = (unsigned)(lo >> 32); vw.z = (unsigned)hi8; vw.w = (unsigned)(hi8 >> 32);
                o[dh] = __builtin_amdgcn_mfma_f32_32x32x16_bf16(__builtin_bit_cast(bf16x8, vw), pf, o[dh], 0, 0, 0);
            }
        }
}
template <int VS, bool SMP>
__device__ __forceinline__ void attn_job(LAS const unsigned char* Kl, LAS const unsigned char* Vl, LAS unsigned char* stg, const bf16_t* Q, const bf16_t* SGA, bf16_t* MIX, size_t row0, int head0, int kt0, int qi, int kjmin, float sink2, int lane) {
    const int l31 = lane & 31, hi = lane >> 5;
    const size_t qrow = SMP ? row0 + ((l31 >> 2) & 3) : row0 + l31; const int qhead = SMP ? head0 + (l31 & 3) : head0;
    bf16x8 qf[4];
#pragma unroll
    for (int c = 0; c < 4; ++c) { qf[c] = gld<bf16x8>(Q + qrow * 512 + qhead * 64 + 16 * c + 8 * hi); if (SMP && l31 >= 16) qf[c] = (bf16x8){0, 0, 0, 0, 0, 0, 0, 0}; }
    f32x16 s[5], o[2]; float inv_l;
    attn_qk<VS>(Kl, qf, kt0, qi, kjmin, sink2, lane, s, inv_l);
    const int ch = lane & 3; size_t grow[2]; int gcol[2]; u32x4 g[2][2];
#pragma unroll
    for (int i = 0; i < 2; ++i) { const int rr = (lane >> 2) + 16 * i;
        grow[i] = SMP ? row0 + (rr >> 2) : row0 + rr; gcol[i] = (SMP ? head0 + (rr & 3) : head0) * 64 + 8 * ch;
#pragma unroll
        for (int dh = 0; dh < 2; ++dh) g[i][dh] = (SMP && i == 1) ? (u32x4){0u, 0u, 0u, 0u} : gld<u32x4>(SGA + grow[i] * 512 + gcol[i] + 32 * dh); }
    attn_pv<VS>(Vl, s, kt0, lane, o);
    const int fq = (l31 >> 1) & 3;
#pragma unroll
    for (int dh = 0; dh < 2; ++dh) {
#pragma unroll
        for (int r4 = 0; r4 < 4; ++r4) { f32x4 v; v[0] = o[dh][4 * r4 + 0] * inv_l; v[1] = o[dh][4 * r4 + 1] * inv_l; v[2] = o[dh][4 * r4 + 2] * inv_l; v[3] = o[dh][4 * r4 + 3] * inv_l;
            *(LAS u32x2*)(stg + l31 * 64 + ((r4 ^ fq) * 16) + 8 * hi) = pk4(v); }
        asm volatile("s_waitcnt lgkmcnt(0)" ::: "memory");
#pragma unroll
        for (int i = 0; i < 2; ++i) { if (SMP && i == 1) continue;
            const int rr = (lane >> 2) + 16 * i; const u32x4 w = *(LAS const u32x4*)(stg + rr * 64 + ((ch ^ ((rr >> 1) & 3)) * 16)); const u32x4 gg = g[i][dh];
            u32x4 r; r.x = pk2(bflo(w.x) * bflo(gg.x), bfhi(w.x) * bfhi(gg.x)); r.y = pk2(bflo(w.y) * bflo(gg.y), bfhi(w.y) * bfhi(gg.y)); r.z = pk2(bflo(w.z) * bflo(gg.z), bfhi(w.z) * bfhi(gg.z)); r.w = pk2(bflo(w.w) * bflo(gg.w), bfhi(w.w) * bfhi(gg.w));
            gst<u32x4>(MIX + grow[i] * 1024 + gcol[i] + 32 * dh, r); }
        asm volatile("s_waitcnt lgkmcnt(0)" ::: "memory");
    }
}
__device__ __forceinline__ void unpack8(u32x4 w, float (&f)[8]) { f[0] = bflo(w.x); f[1] = bfhi(w.x); f[2] = bflo(w.y); f[3] = bfhi(w.y); f[4] = bflo(w.z); f[5] = bfhi(w.z); f[6] = bflo(w.w); f[7] = bfhi(w.w); }
template <int NT>
__device__ __forceinline__ void conv_rows(const bf16_t* U, const bf16_t* BGC, bf16_t* MIX, const float* cw, size_t row0, int c0, float (&p2v)[8], float (&p1v)[8]) {
    float w0[8], w1[8], w2[8];
#pragma unroll
    for (int e = 0; e < 8; ++e) { w0[e] = gld<float>(cw + e); w1[e] = gld<float>(cw + 512 + e); w2[e] = gld<float>(cw + 1024 + e); }
    u32x4 ur[NT], br[NT];
#pragma unroll
    for (int i = 0; i < NT; ++i) { ur[i] = gld<u32x4>(U + (row0 + i) * 512 + c0); br[i] = gld<u32x4>(BGC + (row0 + i) * 512 + c0); }
#pragma unroll
    for (int i = 0; i < NT; ++i) {
        float uc[8], bg[8], y[8]; unpack8(ur[i], uc); unpack8(br[i], bg);
#pragma unroll
        for (int e = 0; e < 8; ++e) { y[e] = bg[e] * (w0[e] * p2v[e] + w1[e] * p1v[e] + w2[e] * uc[e]); p2v[e] = p1v[e]; p1v[e] = uc[e]; }
        u32x4 w; w.x = pk2(y[0], y[1]); w.y = pk2(y[2], y[3]); w.z = pk2(y[4], y[5]); w.w = pk2(y[6], y[7]);
        gst<u32x4>(MIX + (row0 + i) * 1024 + 512 + c0, w);
    }
}

struct P2Args { const bf16_t *Q, *K, *V, *SGA, *BGC, *U; bf16_t* MIX; const float *cache_k, *cache_v, *state, *sinks, *conv_w; float* out; };
__device__ __forceinline__ P2Args p2_args() { unsigned char* ws = ka_ws(); return P2Args{(const bf16_t*)(ws + WS_Q), (const bf16_t*)(ws + WS_K), (const bf16_t*)(ws + WS_V), (const bf16_t*)(ws + WS_SGA), (const bf16_t*)(ws + WS_BGC), (const bf16_t*)(ws + WS_U), (bf16_t*)(ws + WS_MIX), ka_in(2), ka_in(3), ka_in(4), ka_in(9), ka_in(10), ka_out()}; }
__device__ __forceinline__ void p2_phase(LAS unsigned char* lds, const int L, const int w0) {
    int tid_ = TID_OF(w0); asm volatile("" : "+v"(tid_));
    const int wid = __builtin_amdgcn_readfirstlane(tid_ >> 6);
#define P2_RELAUNDER() int tid = tid_; asm volatile("" : "+v"(tid)); const int lane = tid & 63, l31 = lane & 31; (void)l31; (void)lane
    LAS unsigned short* vt = (LAS unsigned short*)(lds + VOFF); LAS unsigned short* svt = (LAS unsigned short*)(lds + SV_OFF);
    for (int item = blockIdx.x; item < 256; item += gridDim.x) {
        const P2Args A = p2_args();
        const int b = item >> 5, n = (item >> 1) & 15, kvh = item & 1, sb = item >> 1;
        const size_t cb = ((size_t)(L * 128 + sb) * 128) * 128 + kvh * 64;
        __syncthreads();
        {
            P2_RELAUNDER();
            u32x4 kv[4], vv[4]; f32x4 kq[4], vq[4];
#pragma unroll
            for (int it = 0; it < 4; ++it) {
                const int idx = it * 512 + tid, kj = idx >> 3, ch = idx & 7, kp = 128 * (n - 1) + kj;
                kv[it] = (u32x4){0u, 0u, 0u, 0u}; vv[it] = (u32x4){0u, 0u, 0u, 0u};
                if (kp >= 0) { const size_t r = (size_t)(b * 2048 + kp); kv[it] = gld<u32x4>(A.K + r * 128 + kvh * 64 + ch * 8); vv[it] = gld<u32x4>(A.V + r * 128 + kvh * 64 + ch * 8); }
                const int j = idx >> 4, c16 = idx & 15;
                kq[it] = gld_nt<f32x4>(A.cache_k + cb + (size_t)j * 128 + c16 * 4); vq[it] = gld_nt<f32x4>(A.cache_v + cb + (size_t)j * 128 + c16 * 4);
            }
#pragma unroll
            for (int it = 0; it < 4; ++it) {
                const int idx = it * 512 + tid, kj = idx >> 3, ch = idx & 7;
                *(LAS u32x4*)(lds + kj * KSTR + ch * 16) = kv[it];
#pragma unroll
                for (int e = 0; e < 8; ++e) { const unsigned w = vv[it][e >> 1]; vt[(ch * 8 + e) * (VSTR / 2) + kj] = (unsigned short)((e & 1) ? (w >> 16) : (w & 0xffffu)); }
                const int j = idx >> 4, c16 = idx & 15;
                *(LAS u32x2*)(lds + SK_OFF + j * KSTR + c16 * 8) = pk4(kq[it]);
                const u32x2 vw = pk4(vq[it]);
                svt[(c16 * 4 + 0) * (VSTR_S / 2) + j] = (unsigned short)(vw.x & 0xffffu); svt[(c16 * 4 + 1) * (VSTR_S / 2) + j] = (unsigned short)(vw.x >> 16);
                svt[(c16 * 4 + 2) * (VSTR_S / 2) + j] = (unsigned short)(vw.y & 0xffffu); svt[(c16 * 4 + 3) * (VSTR_S / 2) + j] = (unsigned short)(vw.y >> 16);
                if (j >= 4) { gst_nt<f32x4>(A.out + O_NKS + cb + (size_t)(j - 4) * 128 + c16 * 4, kq[it]); gst_nt<f32x4>(A.out + O_NVS + cb + (size_t)(j - 4) * 128 + c16 * 4, vq[it]); }
            }
            if (tid < 32) {
                const int t = tid >> 3, ch = tid & 7; const size_t r = (size_t)(NPR + 4 * sb + t);
                const u32x4 k4 = gld<u32x4>(A.K + r * 128 + kvh * 64 + ch * 8), v4 = gld<u32x4>(A.V + r * 128 + kvh * 64 + ch * 8);
                *(LAS u32x4*)(lds + SK_OFF + (128 + t) * KSTR + ch * 16) = k4;
#pragma unroll
                for (int e = 0; e < 8; ++e) { const unsigned w = v4[e >> 1]; svt[(ch * 8 + e) * (VSTR_S / 2) + 128 + t] = (unsigned short)((e & 1) ? (w >> 16) : (w & 0xffffu)); }
            }
            { unsigned z = 0u; asm volatile("" : "+v"(z));
              if (tid < 252) *(LAS u32x4*)(lds + SK_OFF + 132 * KSTR + tid * 16) = (u32x4){z, z, z, z};
              if (tid < 448) { const int d = tid / 7, q = tid % 7; *(LAS u32x2*)(lds + SV_OFF + d * VSTR_S + 264 + q * 8) = (u32x2){z, z}; } }
        }
        __syncthreads();
        const bool jobs_first = ((item >> 3) & 1) == 0;
#pragma unroll 1
        for (int step = 0; step < 2; ++step) {
          if ((step == 0) == jobs_first) {
            {
                P2_RELAUNDER();
                const int head = 4 * kvh + (wid >> 1); const float sink2 = gld<float>(A.sinks + L * 8 + head) * LOG2E;
#pragma unroll 1
                for (int aa = 0; aa < 2; ++aa) {
                    const int a = 2 * (wid & 1) + aa; const size_t row0 = (size_t)(b * 2048 + 128 * n + 32 * a);
                    attn_job<VSTR, false>(lds, lds + VOFF, lds + STG_OFF + wid * 2048, A.Q, A.SGA, A.MIX, row0, head, a, 32 * a + l31, n == 0 ? 128 : 0, sink2, lane);
                }
            }
          } else {
            if (wid == 0) {
                P2_RELAUNDER();
                const int t = (l31 >> 2) & 3, head = 4 * kvh + (l31 & 3); const float sink2 = gld<float>(A.sinks + L * 8 + head) * LOG2E;
                attn_job<VSTR_S, true>(lds + SK_OFF, lds + SV_OFF, lds + STG_OFF, A.Q, A.SGA, A.MIX, (size_t)(NPR + 4 * sb), 4 * kvh, 0, t, 0, sink2, lane);
            } else {
                P2_RELAUNDER();
                const int hw = (wid - 1) * 2 + (lane >> 5), c0 = 256 * kvh + 8 * l31; const float* cw = A.conv_w + (size_t)L * 3 * 512 + c0;
#pragma unroll 1
                for (int un = hw; un < 17; un += 14) {
                    float p2v[8], p1v[8];
                    if (un < 16) {
                        const int t0 = 128 * n + 8 * un; const size_t rb = (size_t)b * 2048;
#pragma unroll
                        for (int e = 0; e < 8; ++e) { p2v[e] = 0.f; p1v[e] = 0.f; }
                        if (t0 >= 2) { unpack8(gld<u32x4>(A.U + (rb + t0 - 2) * 512 + c0), p2v); unpack8(gld<u32x4>(A.U + (rb + t0 - 1) * 512 + c0), p1v); }
                        conv_rows<8>(A.U, A.BGC, A.MIX, cw, rb + t0, c0, p2v, p1v);
                    } else {
                        const float* st = A.state + ((size_t)(L * 128 + sb) * 2) * 512 + c0;
#pragma unroll
                        for (int e = 0; e < 8; ++e) { p2v[e] = gld<float>(st + e); p1v[e] = gld<float>(st + 512 + e); }
                        conv_rows<4>(A.U, A.BGC, A.MIX, cw, (size_t)(NPR + 4 * sb), c0, p2v, p1v);
                    }
                }
            }
          }
        }
    }
    __syncthreads();
#undef P2_RELAUNDER
}

__device__ __forceinline__ float wave_sum(float v) {
#pragma unroll
    for (int o = 1; o < 64; o <<= 1) v += __shfl_xor(v, o);
    return v;
}
__device__ __forceinline__ int win_src_col(int nb) {
    const int pn = nb >> 3, q = nb & 7, bj = q >> 2, wc = q & 3;
    if (pn < 2) return (4 * pn + wc) * 64 + 32 * bj;
    if (pn == 2) return wc < 2 ? 512 + wc * 64 + 32 * bj : 640 + 64 * bj + (wc - 2) * 32;
    if (pn < 5) return 768 + (pn - 3) * 256 + q * 32;
    if (pn < 9) return (bj == 0 ? 1280 : 2816) + 128 * (pn - 5) + wc * 32;
    return (bj == 0 ? 1792 : 2304) + 128 * (pn - 9) + wc * 32;
}
__device__ __forceinline__ void tr_item64(const float* W, int N, int K, int src_a, int src_b, const float* g, bf16_t* WT, int dst_row0, int k0, LAS float* scr, int lane) {
    const int sc = (lane < 32 ? src_a : src_b) + (lane & 31);
    float v[64];
#pragma unroll
    for (int kk = 0; kk < 64; ++kk) v[kk] = gld_nt<float>(W + (size_t)(k0 + kk) * N + sc);
#pragma unroll
    for (int kk = 0; kk < 64; ++kk) scr[kk * 65 + lane] = g ? v[kk] * gld<float>(g + k0 + kk) : v[kk];
    asm volatile("s_waitcnt lgkmcnt(0)" ::: "memory");
    const int c = lane & 7;
#pragma unroll
    for (int j = 0; j < 8; ++j) { const int n = (lane >> 3) + 8 * j; const LAS float* sp = scr + (8 * c) * 65 + n;
        u32x4 o; o.x = pk2(sp[0 * 65], sp[1 * 65]); o.y = pk2(sp[2 * 65], sp[3 * 65]); o.z = pk2(sp[4 * 65], sp[5 * 65]); o.w = pk2(sp[6 * 65], sp[7 * 65]);
        gst<u32x4>(WT + (size_t)(dst_row0 + n) * K + k0 + 8 * c, o); }
    asm volatile("s_waitcnt lgkmcnt(0)" ::: "memory");
}
struct Args { const float* in[15]; float* out; unsigned char* ws; int ph_lo, ph_hi; };
__device__ __forceinline__ void p0_phase(LAS unsigned char* lds, const Args& a, const int w0) {
    const int tid = TID_OF(w0), lane = tid & 63, wid = __builtin_amdgcn_readfirstlane(tid >> 6);
    const int gw = blockIdx.x * 8 + wid, NGW = gridDim.x * 8;
    LAS float* scr = (LAS float*)(lds + wid * 16640);
    unsigned char* ws = a.ws;
    constexpr int I_IN = DEPTH * 52 * 16, I_SQ = DEPTH * 16 * 16, I_PP = DEPTH * 16 * 4;
    for (int it = gw; it < I_IN + 2 * I_SQ + I_PP; it += NGW) {
        int r = it;
        if (r < I_IN) { const int L = r / (52 * 16), q = r % (52 * 16), nb = q % 52, kb = q / 52;
            tr_item64(a.in[8] + (size_t)L * DM * INW, INW, DM, win_src_col(2 * nb), win_src_col(2 * nb + 1), a.in[7] + L * DM, (bf16_t*)(ws + WS_WIN) + (size_t)L * INW * DM, nb * 64, kb * 64, scr, lane); continue; }
        r -= I_IN;
        if (r < 2 * I_SQ) { const int which = r / I_SQ; r %= I_SQ; const int L = r / 256, q = r % 256, nb = q & 15, kb = q >> 4;
            tr_item64(a.in[which ? 12 : 11] + (size_t)L * DM * DM, DM, DM, nb * 64, nb * 64 + 32, nullptr, (bf16_t*)(ws + (which ? WS_WPG : WS_WOUT)) + (size_t)L * DM * DM, nb * 64, kb * 64, scr, lane); continue; }
        r -= 2 * I_SQ;
        { const int L = r / 64, q = r % 64, nb = q & 15, kb = q >> 4;
            tr_item64(a.in[13] + (size_t)L * PLE * DM, DM, PLE, nb * 64, nb * 64 + 32, nullptr, (bf16_t*)(ws + WS_WPP) + (size_t)L * DM * PLE, nb * 64, kb * 64, scr, lane); }
    }
    for (int row = gw; row < MR; row += 2 * NGW) {
        const int row1 = row + NGW; const bool has1 = row1 < MR; const int r1 = has1 ? row1 : row;
        const float* xr0 = row < NPR ? a.in[0] + (size_t)row * DM : a.in[1] + (size_t)(row - NPR) * DM;
        const float* xr1 = r1 < NPR ? a.in[0] + (size_t)r1 * DM : a.in[1] + (size_t)(r1 - NPR) * DM;
        f32x4 v0[4], v1[4];
#pragma unroll
        for (int j = 0; j < 4; ++j) { v0[j] = gld_nt<f32x4>(xr0 + 4 * lane + 256 * j); v1[j] = gld_nt<f32x4>(xr1 + 4 * lane + 256 * j); }
        float s0 = 0.f, s1 = 0.f;
        bf16_t* xb0 = (bf16_t*)(ws + WS_XB0) + (size_t)row * DM; bf16_t* xb1 = (bf16_t*)(ws + WS_XB0) + (size_t)r1 * DM;
#pragma unroll
        for (int j = 0; j < 4; ++j) { s0 += (v0[j][0] * v0[j][0] + v0[j][1] * v0[j][1]) + (v0[j][2] * v0[j][2] + v0[j][3] * v0[j][3]); s1 += (v1[j][0] * v1[j][0] + v1[j][1] * v1[j][1]) + (v1[j][2] * v1[j][2] + v1[j][3] * v1[j][3]);
            *(u32x2*)(xb0 + 4 * lane + 256 * j) = pk4(v0[j]); if (has1) *(u32x2*)(xb1 + 4 * lane + 256 * j) = pk4(v1[j]); }
        s0 = wave_sum(s0); s1 = wave_sum(s1);
        if (lane < 16) { ((float*)(ws + WS_SSP))[(size_t)row * 16 + lane] = lane == 0 ? s0 : 0.f; if (has1) ((float*)(ws + WS_SSP))[(size_t)row1 * 16 + lane] = lane == 0 ? s1 : 0.f; }
    }
    const int gt = blockIdx.x * 512 + tid, GT = gridDim.x * 512;
    for (int i = gt; i < DEPTH * MR * 64; i += 4 * GT) {
        f32x4 v[4];
#pragma unroll
        for (int j = 0; j < 4; ++j) { const int ii = i + j * GT; const int ic = ii < DEPTH * MR * 64 ? ii : i; const int L = ic / (MR * 64), q = ic % (MR * 64), row = q >> 6, c4 = q & 63;
            const float* src = row < NPR ? a.in[5] + ((size_t)L * NPR + row) * PLE : a.in[6] + ((size_t)L * NSR + row - NPR) * PLE; v[j] = gld_nt<f32x4>(src + c4 * 4); }
#pragma unroll
        for (int j = 0; j < 4; ++j) { const int ii = i + j * GT; if (ii < DEPTH * MR * 64) *(u32x2*)((bf16_t*)(ws + WS_PB) + (size_t)ii * 4) = pk4(v[j]); }
    }
    for (int i = gt; i < 2052 * 32; i += GT) {
        const int pidx = i >> 5, d = i & 31; const double pos = pidx < 2048 ? (double)pidx : (double)(8192 + pidx - 2048);
        double inv = 1.0; for (int k = 0; k < d; ++k) inv *= 0.74989420933245582730;
        double rev = pos * inv * 0.15915494309189533577; rev -= __builtin_floor(rev);
        const float f = (float)rev; float* tp = (float*)(ws + WS_TAB) + (size_t)pidx * 64 + d;
        tp[0] = __builtin_amdgcn_cosf(f); tp[32] = __builtin_amdgcn_sinf(f);
    }
}
__device__ __forceinline__ void final_phase(const int w0) {
    int tid_ = TID_OF(w0); asm volatile("" : "+v"(tid_)); const int tid = tid_, lane = tid & 63, wid = tid >> 6; const int gw = blockIdx.x * 8 + wid, NGW = gridDim.x * 8;
    unsigned char* ws = ka_ws(); const float* ssp = (const float*)(ws + WS_SSP); const bf16_t* X0 = (const bf16_t*)(ws + WS_XB0); const float* gf = ka_in(14); float* outp = ka_out();
    f32x4 g[4];
#pragma unroll
    for (int j = 0; j < 4; ++j) g[j] = gld<f32x4>(gf + 4 * lane + 256 * j);
    for (int row = gw; row < MR; row += 2 * NGW) {
        const int row1 = row + NGW; const bool has1 = row1 < MR; const int r1 = has1 ? row1 : row;
        float s0 = lane < 16 ? gld<float>(ssp + (size_t)row * 16 + lane) : 0.f, s1 = lane < 16 ? gld<float>(ssp + (size_t)r1 * 16 + lane) : 0.f;
        u32x2 v0[4], v1[4];
#pragma unroll
        for (int j = 0; j < 4; ++j) { v0[j] = gld<u32x2>(X0 + (size_t)row * DM + 4 * lane + 256 * j); v1[j] = gld<u32x2>(X0 + (size_t)r1 * DM + 4 * lane + 256 * j); }
        s0 = wave_sum(s0); s1 = wave_sum(s1);
        const float rs0 = __builtin_amdgcn_rsqf(s0 * (1.f / 1024.f) + EPS), rs1 = __builtin_amdgcn_rsqf(s1 * (1.f / 1024.f) + EPS);
#pragma unroll
        for (int j = 0; j < 4; ++j) { gst_nt<f32x4>(outp + (size_t)row * DM + 4 * lane + 256 * j, bf4(v0[j]) * rs0 * g[j]); if (has1) gst_nt<f32x4>(outp + (size_t)row1 * DM + 4 * lane + 256 * j, bf4(v1[j]) * rs1 * g[j]); }
    }
}

#define RLX_AGENT __ATOMIC_RELAXED, __HIP_MEMORY_SCOPE_AGENT
#define XB_TMO      128
#define XB_XCNT(j)  (256  + 64 * (j))
#define XB_XSUB(j)  (1280 + 64 * (j))
#define XB_XGEN(j)  (2304 + 64 * (j))
#define XB_TOP      3328
#define XB_TOPGEN   3392
#define XCD_BAR_WORDS 3456
#define XB_SPIN_CAP (1u << 18)

__device__ __forceinline__ unsigned xb_ld(unsigned* p)              { return __hip_atomic_load((GAS unsigned*)p, __ATOMIC_RELAXED, __HIP_MEMORY_SCOPE_AGENT); }
__device__ __forceinline__ unsigned xb_add(unsigned* p, unsigned v) { return __hip_atomic_fetch_add((GAS unsigned*)p, v, __ATOMIC_RELAXED, __HIP_MEMORY_SCOPE_AGENT); }
__device__ __forceinline__ unsigned xb_xcc_id() { return (unsigned)__builtin_amdgcn_s_getreg((3 << 11) | 20) & 0xFu; }
#define XB_SPIN(cond, bar) do { unsigned _sp = 0; while (cond) { __builtin_amdgcn_s_sleep(1); \
    if ((++_sp & 255u) == 0u) { if (xb_ld(&(bar)[XB_TMO])) break; if (_sp > XB_SPIN_CAP) { atomicAdd(&(bar)[XB_TMO], 1u); break; } } } } while (0)

struct XcdBarrier {
    unsigned* bar; unsigned x; int w0;
    volatile LAS unsigned* st;
};

__device__ __forceinline__ XcdBarrier xcd_barrier_post(unsigned* bar, volatile LAS unsigned* st, int w0) {
    XcdBarrier b; b.bar = bar; b.x = xb_xcc_id(); b.st = st; b.w0 = w0;
    if (TID_OF(w0) == 0) (void)xb_add(&bar[XB_XCNT(b.x)], 1u);
    return b;
}
__device__ __forceinline__ void xcd_barrier_complete(unsigned* bar, unsigned x, unsigned& nloc, unsigned& nx) {
    const unsigned G = gridDim.x * gridDim.y * gridDim.z;
    unsigned sum, cnt, mine, sp = 0u;
    for (;;) {
        sum = 0u; cnt = 0u; mine = 0u;
#pragma unroll
        for (unsigned j = 0; j < 16; ++j) { const unsigned c = xb_ld(&bar[XB_XCNT(j)]); sum += c; cnt += (c > 0u) ? 1u : 0u; mine = (j == x) ? c : mine; }
        if (sum == G) break;
        __builtin_amdgcn_s_sleep(1);
        if ((++sp & 255u) == 0u) { if (xb_ld(&bar[XB_TMO])) break; if (sp > XB_SPIN_CAP) { atomicAdd(&bar[XB_TMO], 1u); break; } }
    }
    nloc = mine > 0u ? mine : 1u; nx = cnt > 0u ? cnt : 1u;
}

__device__ __forceinline__ void xcd_barrier(const XcdBarrier& b) {
    asm volatile("s_waitcnt vmcnt(0)" ::: "memory");
    __syncthreads();
    if (TID_OF(b.w0) == 0) {
        unsigned* bar = b.bar; unsigned bx = b.x; asm volatile("" : "+s"(bar), "+s"(bx));
        __builtin_amdgcn_s_waitcnt(0);
        unsigned nloc = b.st[0], nx = b.st[1];
        if (nloc == 0u) { xcd_barrier_complete(bar, bx, nloc, nx); b.st[0] = nloc; b.st[1] = nx; }
        const unsigned old = xb_add(&bar[XB_XSUB(bx)], 1u);
        const unsigned gen = old / nloc;
        if (old + 1u == (gen + 1u) * nloc) {
            __builtin_amdgcn_fence(__ATOMIC_RELEASE, "agent");
            asm volatile("s_waitcnt vmcnt(0)" ::: "memory");
            const unsigned og = xb_add(&bar[XB_TOP], 1u);
            const unsigned tg = og / nx;
            if (og + 1u == (tg + 1u) * nx) xb_add(&bar[XB_TOPGEN], 1u);
            else XB_SPIN(xb_ld(&bar[XB_TOPGEN]) == tg, bar);
            __builtin_amdgcn_fence(__ATOMIC_ACQUIRE, "agent");
            xb_add(&bar[XB_XGEN(bx)], 1u);
            asm volatile("s_waitcnt vmcnt(0)" ::: "memory");
        } else {
            XB_SPIN(xb_ld(&bar[XB_XGEN(bx)]) == gen, bar);
            __builtin_amdgcn_fence(__ATOMIC_ACQUIRE, "agent");
            asm volatile("s_waitcnt vmcnt(0)" ::: "memory");
        }
    }
    __syncthreads();
}

#ifndef MK_SPLIT
#define MK_SPLIT 0
#endif
__device__ __forceinline__ unsigned char* opq(unsigned char* p) { asm volatile("" : "+s"(p)); return p; }
__global__ void __launch_bounds__(512, 2) fwd(Args a) {
    extern __shared__ __attribute__((aligned(16))) unsigned char lds_raw[];
    LAS unsigned char* lds = (LAS unsigned char*)lds_raw;
    cg::grid_group grid = cg::this_grid();
    volatile LAS unsigned* misc = (volatile LAS unsigned*)(lds + 139264);
    if (a.ph_hi == 0x7fffffff) grid.sync();
    const int w0 = __builtin_amdgcn_readfirstlane((int)threadIdx.x >> 6);
    if (TID_OF(w0) < 16) misc[TID_OF(w0)] = 0u;
    __syncthreads();
    const XcdBarrier bar = xcd_barrier_post((unsigned*)(a.ws + WS_BAR), misc, w0);
    const int G = gridDim.x, c = blockIdx.x;
#if MK_SPLIT
    const int lo = a.ph_lo, hi = a.ph_hi;
#define IN(k) (lo <= (k) && (k) < hi)
#define SEAM(k) do { if (IN(k) && IN((k) + 1)) grid.sync(); } while (0)
#else
#define IN(k) true
#define SEAM(k) xcd_barrier(bar)
#endif
#ifndef DIS_P0
    if (IN(0)) p0_phase(lds, a, w0);
#endif
    SEAM(0);
#pragma unroll 1
    for (int L = 0; L < DEPTH; ++L) {
        const int ph = 1 + 4 * L;
        if (IN(ph)) {
            int cp_ = c; asm volatile("" : "+s"(cp_)); const bool pp_first = ((cp_ >> 3) & 1) != 0;
#pragma unroll 1
            for (int step = 0; step < 2; ++step) {
                if ((step == 0) != pp_first) {
                    unsigned char* ws = ka_ws();
                    pg8::Gemm g{(const bf16_t*)(ws + WS_XB0), (const bf16_t*)(ws + WS_WIN) + (size_t)L * INW * DM, MR, INW, DM}; int c1_ = c; asm volatile("" : "+s"(c1_)); pg8::StaticOrder S; S.init(MR, INW, G, c1_);
                    EpiIn E{L};
                    pg8::gemm_phase<EpiIn, pg8::StaticOrder, true, true>(lds, g, S, E, w0);
                } else {
                    unsigned char* ws = ka_ws();
                    pg8::Gemm g{(const bf16_t*)(ws + WS_PB) + (size_t)L * MR * PLE, (const bf16_t*)(ws + WS_WPP) + (size_t)L * DM * PLE, MR, DM, PLE};
                    const int nu = (MR / 256) * (INW / 256); int c2_ = c; asm volatile("" : "+s"(c2_)); FillOrder S; S.init(MR, DM, G, c2_, nu % G);
                    EpiPP E{0};
                    pg8::gemm_phase<EpiPP, FillOrder, true, true>(lds, g, S, E, w0);
                }
            }
        }
        SEAM(ph);
        if (IN(ph + 1)) {
#ifndef DIS_P2
            unsigned char* ws = ka_ws();
            p2_phase(lds, L, w0);
#endif
        }
        SEAM(ph + 1);
        if (IN(ph + 2)) {
#ifndef DIS_P3A
            unsigned char* ws = ka_ws();
            pg8::Gemm g{(const bf16_t*)(ws + WS_MIX), (const bf16_t*)(ws + WS_WOUT) + (size_t)L * DM * DM, NPR, DM, DM}; pg8::StaticOrder S; S.init(NPR, DM, G, c);
            EpiOut E{0};
            int cb_ = c; asm volatile("" : "+s"(cb_)); const bool small_first = ((cb_ >> 3) & 1) == 0;
#pragma unroll 1
            for (int step = 0; step < 2; ++step) {
                if ((step == 0) == small_first) small_gemm<EpiOut>(lds, g.A + (size_t)NPR * DM, g.Bt, E, w0);
                else pg8::gemm_phase<EpiOut, pg8::StaticOrder, true, true>(lds, g, S, E, w0);
            }
#endif
        }
        SEAM(ph + 2);
        if (IN(ph + 3)) {
#ifndef DIS_P3B
            unsigned char* ws = ka_ws();
            pg8::Gemm g{(const bf16_t*)(ws + WS_XB1), (const bf16_t*)(ws + WS_WPG) + (size_t)L * DM * DM, NPR, DM, DM}; pg8::StaticOrder S; S.init(NPR, DM, G, c);
            EpiGate E{0};
            int cb_ = c; asm volatile("" : "+s"(cb_)); const bool small_first = ((cb_ >> 3) & 1) == 0;
#pragma unroll 1
            for (int step = 0; step < 2; ++step) {
                if ((step == 0) == small_first) small_gemm<EpiGate>(lds, g.A + (size_t)NPR * DM, g.Bt, E, w0);
                else pg8::gemm_phase<EpiGate, pg8::StaticOrder, true, true>(lds, g, S, E, w0);
            }
#endif
        }
        SEAM(ph + 3);
    }
    if (IN(17)) final_phase(w0);
#undef IN
#undef SEAM
}

extern "C" void kernel_launch(void* const* d_in, const int* in_sizes, int n_in, void* d_out, int out_size, void* d_ws, size_t ws_size, hipStream_t stream) {
    static int grid = 0;
    if (grid == 0) {
        if (n_in != 15 || (size_t)out_size != O_END || ws_size < WS_END) { fprintf(stderr, "kernel_launch: unexpected shapes (n_in %d out %d ws %zu)\n", n_in, out_size, ws_size); grid = -1; return; }
        int dev = 0, cus = 0, per = 0;
        if (hipGetDevice(&dev) != hipSuccess || hipDeviceGetAttribute(&cus, hipDeviceAttributeMultiprocessorCount, dev) != hipSuccess) { grid = -1; return; }
        if (hipFuncSetAttribute((const void*)fwd, hipFuncAttributeMaxDynamicSharedMemorySize, LDS_BYTES) != hipSuccess) { fprintf(stderr, "kernel_launch: hipFuncSetAttribute failed\n"); grid = -1; return; }
        if (hipOccupancyMaxActiveBlocksPerMultiprocessor(&per, (const void*)fwd, 512, LDS_BYTES) != hipSuccess || per < 1) { fprintf(stderr, "kernel_launch: occupancy query %d\n", per); per = 1; }
        (void)hipGetLastError();
        grid = cus;
        fprintf(stderr, "kernel_launch: grid %d (cus %d x per_cu %d), ws %zu\n", grid, cus, per, ws_size);
    }
    if (grid < 0) return;
    if (hipMemsetAsync((char*)d_ws + WS_BAR, 0, 16384, stream) != hipSuccess) { fprintf(stderr, "kernel_launch: memset failed\n"); return; }
    Args a{};
    for (int i = 0; i < 15; ++i) a.in[i] = (const float*)d_in[i];
    a.out = (float*)d_out; a.ws = (unsigned char*)d_ws;
#if MK_SPLIT
    for (int ph = 0; ph < 18; ++ph) { a.ph_lo = ph; a.ph_hi = ph + 1; hipLaunchKernelGGL(fwd, dim3(grid), dim3(512), LDS_BYTES, stream, a); }
#else
    a.ph_lo = 0; a.ph_hi = 18;
    void* args[] = {&a};
    const hipError_t e = hipLaunchCooperativeKernel((const void*)fwd, dim3(grid), dim3(512), args, LDS_BYTES, stream);
    if (e != hipSuccess) fprintf(stderr, "kernel_launch: cooperative launch failed: %s (grid %d)\n", hipGetErrorString(e), grid);
#endif
}
```

```cpp
#include <hip/hip_runtime.h>
#include <hip/hip_cooperative_groups.h>
#include <cstdio>
#include <cstdint>
namespace cg = cooperative_groups;
__device__ __forceinline__ int lane_id() { int l; asm volatile("v_mbcnt_lo_u32_b32 %0, -1, 0\n\tv_mbcnt_hi_u32_b32 %0, -1, %0" : "=v"(l)); return l; }
#define TID_OF(w0) ((w0) * 64 + lane_id())
namespace pg8 {
#define PG8_LAS __attribute__((address_space(3)))
typedef unsigned short bf16_t;
typedef short bf16x8 __attribute__((ext_vector_type(8)));
typedef float f32x4 __attribute__((ext_vector_type(4)));
typedef unsigned u32x4 __attribute__((ext_vector_type(4)));
constexpr int BM = 256, BK = 64, HALF = 128, HTB = HALF * BK * 2  , STAGE_BYTES = 8 * HTB, NXCD = 8, WGM = 8;

__host__ __device__ __forceinline__ int lds_byte(int r, int c) { const int st = (r >> 4) * 2 + (c >> 5), rr = r & 15, cc = c & 31, ob = rr * 64 + cc * 2; return st * 1024 + (ob ^ (((ob >> 9) & 1) << 5)); }
__host__ __device__ __forceinline__ void stage_rc(int b, int& R, int& C) { const int st = b / 1024, sb = b % 1024, swz = sb ^ (((sb >> 9) & 1) << 5); R = (st >> 1) * 16 + swz / 64; C = (st & 1) * 32 + (swz % 64) / 2; }
__host__ __device__ __forceinline__ int perm32(int rho) { const int n = rho >> 4, i = rho & 15; return 8 * (i >> 2) + 4 * n + (i & 3); }

struct Unit { int pm, pn; };
struct Gemm { const bf16_t* A; const bf16_t* Bt; int M, N, K; };

struct StaticOrder {
    int nM, nN, nwg, G, c;
    __host__ __device__ void init(int M, int N, int G_, int c_) { nM = M / BM; nN = N / BM; nwg = nM * nN; G = G_; c = c_; }
    __host__ __device__ bool next(int i, Unit& u) const {
        const long L = (long)i * G + c; if (L >= nwg) return false;
        int wgid = (int)L; { const int q = nwg / NXCD, r = nwg % NXCD, xcd = wgid % NXCD, off = wgid / NXCD; wgid = (xcd < r ? xcd * (q + 1) : r * (q + 1) + (xcd - r) * q) + off; }
        const int nig = WGM * nN, gid = wgid / nig, fm = gid * WGM, gsz = (nM - fm) < WGM ? (nM - fm) : WGM;
        u.pm = fm + ((wgid % nig) % gsz); u.pn = (wgid % nig) / gsz; return true;
    }
    __device__ __forceinline__ void a_ready(const Unit&) const {}
    __device__ __forceinline__ void done(const Unit&) const {}
};

__device__ __forceinline__ unsigned cvt_pk_bf16(float lo, float hi) { unsigned r; asm volatile("v_cvt_pk_bf16_f32 %0, %1, %2" : "=v"(r) : "v"(lo), "v"(hi)); return r; }
typedef float f32x2 __attribute__((ext_vector_type(2)));
template <class Epi, class Sched, bool ALIGN_EPI = false, bool SP2 = false>
__device__ __forceinline__ void gemm_phase(PG8_LAS unsigned char* lds, const Gemm g, const Sched& S, const Epi& E, const int w0) {
    int tid_ = TID_OF(w0); asm volatile("" : "+v"(tid_));
    const int tid = tid_, wid = __builtin_amdgcn_readfirstlane(tid >> 6), lane = tid & 63, wr = wid >> 2, wc = wid & 3, fr = lane & 15, fq = lane >> 4;
    const int K = g.K, nt = K / BK;
    unsigned voffA[2], voffB[2];
#pragma unroll
    for (int i = 0; i < 2; ++i) { int R, C; stage_rc(tid * 16 + i * 8192, R, C); const int Rb = Epi::PERM ? ((R & ~31) + perm32(R & 31)) : R;
        voffA[i] = (unsigned)(R * K + C) * 2u; voffB[i] = (unsigned)(Rb * K + C) * 2u; }
    const size_t kstep = (size_t)(BK * 2);
    const size_t hstep = (size_t)HALF * K * 2;
    const size_t tstep = 2 * hstep;
    const unsigned ldsw = (unsigned)wid * 1024u;
    const int aoff = lds_byte(wr * 64 + fr, fq * 8), boff = lds_byte(wc * 32 + fr, fq * 8);
#define PG8_SA(b, h) (((b) * 2 + (h)) * HTB)
#define PG8_SB(b, h) ((4 + (b) * 2 + (h)) * HTB)
#define PG8_STAGE(bufoff, gbase, voff) do { _Pragma("unroll") for (int _i = 0; _i < 2; ++_i) \
        __builtin_amdgcn_global_load_lds((const unsigned*)((const char*)(gbase) + (voff)[_i]), (PG8_LAS unsigned*)(lds + (bufoff) + ldsw + _i * 8192), 16, 0, 0); } while (0)
#define PG8_LDA(dst, b, h) do { _Pragma("unroll") for (int m = 0; m < 4; ++m) _Pragma("unroll") for (int k = 0; k < 2; ++k) dst[m][k] = *(const PG8_LAS bf16x8*)(lds + PG8_SA(b, h) + aoff + m * 2048 + k * 1024); } while (0)
#define PG8_LDB(dst, b, h) do { _Pragma("unroll") for (int n = 0; n < 2; ++n) _Pragma("unroll") for (int k = 0; k < 2; ++k) dst[n][k] = *(const PG8_LAS bf16x8*)(lds + PG8_SB(b, h) + boff + n * 2048 + k * 1024); } while (0)
#define PG8_MMA(ai, bj, At, Bt) do { __builtin_amdgcn_s_setprio(1); _Pragma("unroll") for (int m = 0; m < 4; ++m) _Pragma("unroll") for (int n = 0; n < 2; ++n) _Pragma("unroll") for (int k = 0; k < 2; ++k) \
        acc[ai][bj][m][n] = __builtin_amdgcn_mfma_f32_16x16x32_bf16(Bt[n][k], At[m][k], acc[ai][bj][m][n], 0, 0, 0); __builtin_amdgcn_s_setprio(0); } while (0)
#define PG8_WAIT_V(n) asm volatile("s_waitcnt vmcnt(" #n ")" ::: "memory")
#define PG8_WAIT_L(n) asm volatile("s_waitcnt lgkmcnt(" #n ")" ::: "memory")
#define PG8_BAR __builtin_amdgcn_s_barrier()
#define PG8_SCHED __builtin_amdgcn_sched_barrier(0)
    Unit cur, nxt; int ui = 0;
    if (!S.next(0, cur)) return;
    f32x4 acc[2][2][4][2];
#pragma unroll
    for (int a = 0; a < 2; ++a)
#pragma unroll
        for (int b = 0; b < 2; ++b)
#pragma unroll
            for (int m = 0; m < 4; ++m)
#pragma unroll
                for (int n = 0; n < 2; ++n) acc[a][b][m][n] = (f32x4){0.f, 0.f, 0.f, 0.f};
    bf16x8 At[4][2], B0[2][2], B1[2][2];
    const char* cA = (const char*)g.A + (size_t)cur.pm * tstep; const char* cB = (const char*)g.Bt + (size_t)cur.pn * tstep;
    S.a_ready(cur);
    if constexpr (SP2) {
        PG8_STAGE(PG8_SB(0, 0), cB, voffB); PG8_STAGE(PG8_SB(0, 1), cB + hstep, voffB); PG8_STAGE(PG8_SA(0, 0), cA, voffA); PG8_STAGE(PG8_SA(0, 1), cA + hstep, voffA);
        if (wr == 1) PG8_BAR;
        PG8_WAIT_V(2); PG8_BAR;
        PG8_STAGE(PG8_SB(1, 0), cB + kstep, voffB); PG8_STAGE(PG8_SA(1, 0), cA + kstep, voffA); PG8_STAGE(PG8_SB(1, 1), cB + hstep + kstep, voffB);
        PG8_WAIT_V(6); PG8_BAR;
    } else {
        PG8_STAGE(PG8_SB(0, 0), cB, voffB); PG8_STAGE(PG8_SA(0, 0), cA, voffA); PG8_STAGE(PG8_SB(0, 1), cB + hstep, voffB); PG8_STAGE(PG8_SA(0, 1), cA + hstep, voffA);
        if (wr == 1) PG8_BAR;
        PG8_WAIT_V(4); PG8_BAR;
        PG8_STAGE(PG8_SB(1, 0), cB + kstep, voffB); PG8_STAGE(PG8_SA(1, 0), cA + kstep, voffA); PG8_STAGE(PG8_SB(1, 1), cB + hstep + kstep, voffB);
        PG8_WAIT_V(6); PG8_BAR;
    }
    for (;;) {
        const bool has_next = S.next(ui + 1, nxt);
        const char* nA = has_next ? (const char*)g.A + (size_t)nxt.pm * tstep : cA; const char* nB = has_next ? (const char*)g.Bt + (size_t)nxt.pn * tstep : cB;
#pragma unroll 1
        for (int t = 0; t < nt; t += 2) {
            const bool last = (t == nt - 2);
            const char* a1 = cA + (size_t)(t + 1) * kstep;
            const char* a2 = last ? nA : cA + (size_t)(t + 2) * kstep; const char* b2 = last ? nB : cB + (size_t)(t + 2) * kstep;
            const char* a3 = a2 + kstep; const char* b3 = b2 + kstep;
            if (last && has_next) S.a_ready(nxt);
            if constexpr (SP2) {
            PG8_LDB(B0, 0, 0); PG8_LDB(B1, 0, 1); PG8_SCHED; PG8_LDA(At, 0, 0); PG8_STAGE(PG8_SA(1, 1), a1 + hstep, voffA);
            PG8_WAIT_V(8); PG8_WAIT_L(0); PG8_BAR; PG8_MMA(0, 0, At, B0); PG8_MMA(0, 1, At, B1); PG8_BAR; PG8_SCHED;
            PG8_LDA(At, 0, 1); PG8_STAGE(PG8_SB(0, 0), b2, voffB); PG8_STAGE(PG8_SB(0, 1), b2 + hstep, voffB); PG8_STAGE(PG8_SA(0, 0), a2, voffA);
            PG8_WAIT_V(8); PG8_WAIT_L(0); PG8_BAR; PG8_MMA(1, 0, At, B0); PG8_MMA(1, 1, At, B1); PG8_BAR; PG8_SCHED;
            PG8_LDB(B0, 1, 0); PG8_LDB(B1, 1, 1); PG8_SCHED; PG8_LDA(At, 1, 0); PG8_STAGE(PG8_SA(0, 1), a2 + hstep, voffA);
            PG8_WAIT_V(8); PG8_WAIT_L(0); PG8_BAR; PG8_MMA(0, 0, At, B0); PG8_MMA(0, 1, At, B1); PG8_BAR; PG8_SCHED;
            PG8_LDA(At, 1, 1); PG8_STAGE(PG8_SB(1, 0), b3, voffB); PG8_STAGE(PG8_SB(1, 1), b3 + hstep, voffB); PG8_STAGE(PG8_SA(1, 0), a3, voffA);
            PG8_WAIT_V(8); PG8_WAIT_L(0); PG8_BAR; PG8_MMA(1, 0, At, B0); PG8_MMA(1, 1, At, B1); PG8_BAR; PG8_SCHED;
            } else {
            PG8_LDB(B0, 0, 0); PG8_SCHED; PG8_LDA(At, 0, 0); PG8_STAGE(PG8_SA(1, 1), a1 + hstep, voffA);
            PG8_WAIT_L(8); PG8_BAR; PG8_WAIT_L(0); PG8_MMA(0, 0, At, B0); PG8_BAR; PG8_SCHED;
            PG8_LDB(B1, 0, 1); PG8_STAGE(PG8_SB(0, 0), b2, voffB);
            PG8_BAR; PG8_WAIT_L(0); PG8_MMA(0, 1, At, B1); PG8_BAR;
            PG8_LDA(At, 0, 1); PG8_STAGE(PG8_SA(0, 0), a2, voffA);
            PG8_BAR; PG8_WAIT_L(0); PG8_MMA(1, 0, At, B0); PG8_BAR; PG8_SCHED;
            PG8_STAGE(PG8_SB(0, 1), b2 + hstep, voffB);
            PG8_WAIT_V(6); PG8_BAR; PG8_MMA(1, 1, At, B1); PG8_BAR;
            PG8_LDB(B0, 1, 0); PG8_SCHED; PG8_LDA(At, 1, 0); PG8_STAGE(PG8_SA(0, 1), a2 + hstep, voffA);
            PG8_WAIT_L(8); PG8_BAR; PG8_WAIT_L(0); PG8_MMA(0, 0, At, B0); PG8_BAR; PG8_SCHED;
            PG8_LDB(B1, 1, 1); PG8_STAGE(PG8_SB(1, 0), b3, voffB);
            PG8_BAR; PG8_WAIT_L(0); PG8_MMA(0, 1, At, B1); PG8_BAR;
            PG8_LDA(At, 1, 1); PG8_STAGE(PG8_SA(1, 0), a3, voffA);
            PG8_BAR; PG8_WAIT_L(0); PG8_MMA(1, 0, At, B0); PG8_BAR; PG8_SCHED;
            PG8_STAGE(PG8_SB(1, 1), b3 + hstep, voffB);
            PG8_WAIT_V(6); PG8_BAR; PG8_MMA(1, 1, At, B1); PG8_BAR;
            }
        }
        if constexpr (ALIGN_EPI) { if (wr == 0) PG8_BAR; }
        if constexpr (!Epi::AFTER_DRAIN) { E(acc, cur, wr, wc, fr, fq); S.done(cur); }
        if (!has_next) break;
#pragma unroll
        for (int a = 0; a < 2; ++a)
#pragma unroll
            for (int b = 0; b < 2; ++b)
#pragma unroll
                for (int m = 0; m < 4; ++m)
#pragma unroll
                    for (int n = 0; n < 2; ++n) acc[a][b][m][n] = (f32x4){0.f, 0.f, 0.f, 0.f};
        cur = nxt; cA = nA; cB = nB; ++ui;
        if constexpr (ALIGN_EPI) { if (wr == 1) PG8_BAR; }
    }
    PG8_WAIT_V(0);
    if constexpr (!ALIGN_EPI) { if (wr == 0) PG8_BAR; }
    PG8_BAR;
    if constexpr (Epi::AFTER_DRAIN) { E.fused(acc, cur, wr, wc, fr, fq, lds, wid, lane); S.done(cur); }
#undef PG8_SA
#undef PG8_SB
#undef PG8_STAGE
#undef PG8_LDA
#undef PG8_LDB
#undef PG8_MMA
#undef PG8_WAIT_V
#undef PG8_WAIT_L
#undef PG8_BAR
#undef PG8_SCHED
}
}

#define GAS __attribute__((address_space(1)))
#define LAS __attribute__((address_space(3)))
using pg8::bf16_t; using pg8::bf16x8; using pg8::f32x4; using pg8::u32x4;
typedef unsigned u32x2 __attribute__((ext_vector_type(2)));
typedef float f32x16 __attribute__((ext_vector_type(16)));
constexpr int DM = 1024, NPR = 16384, NSR = 512, MR = NPR + NSR, DEPTH = 4, INW = 3328, PLE = 256;
constexpr float EPS = 1e-6f, LOG2E = 1.4426950408889634f, QS = 0.125f * 1.4426950408889634f;
constexpr size_t O_NKP = 17301504, O_NVP = 17825792, O_NCP = 18350080, O_NKS = 18382848, O_NVS = 26771456, O_NCS = 35160064, O_END = 35684352;
constexpr size_t MiB = 1u << 20;
constexpr size_t WS_SSP = 0  , WS_TAB = 253 * MiB  , WS_WIN = 2 * MiB, WS_WOUT = 28 * MiB, WS_WPG = 36 * MiB, WS_WPP = 44 * MiB, WS_XB0 = 46 * MiB, WS_PB = 79 * MiB, WS_PP = 112 * MiB,
                 WS_MIX = 145 * MiB, WS_Q = 178 * MiB, WS_SGA = WS_Q + 16 * MiB + MiB / 2, WS_XB1 = WS_Q, WS_BGC = 211 * MiB, WS_U = WS_BGC + 16 * MiB + MiB / 2, WS_K = 244 * MiB,
                 WS_V = WS_K + 4 * MiB + MiB / 8, WS_BAR = 254 * MiB  , WS_END = 255 * MiB;
static_assert(WS_V + 4 * MiB + MiB / 8 <= WS_TAB && WS_TAB + 2052 * 64 * 4 <= WS_BAR && (size_t)MR * 16 * 4 <= 2 * MiB && WS_END <= 256 * MiB, "ws map");
constexpr int LDS_BYTES = 147456;
template <class T, class P> __device__ __forceinline__ T gld(P p) { return *(GAS const T*)p; }
template <class T, class P> __device__ __forceinline__ void gst(P p, T v) { *(GAS T*)p = v; }
template <class T, class P> __device__ __forceinline__ void gst_nt(P p, T v) { __builtin_nontemporal_store(v, (GAS T*)p); }
template <class T, class P> __device__ __forceinline__ T gld_nt(P p) { return __builtin_nontemporal_load((GAS const T*)p); }

__device__ __forceinline__ unsigned pk2(float lo, float hi) { return pg8::cvt_pk_bf16(lo, hi); }
__device__ __forceinline__ u32x4 pk8(f32x4 a, f32x4 b) { u32x4 w; w.x = pk2(a[0], a[1]); w.y = pk2(a[2], a[3]); w.z = pk2(b[0], b[1]); w.w = pk2(b[2], b[3]); return w; }
__device__ __forceinline__ u32x2 pk4(f32x4 a) { u32x2 w; w.x = pk2(a[0], a[1]); w.y = pk2(a[2], a[3]); return w; }
__device__ __forceinline__ float bflo(unsigned w) { return __uint_as_float(w << 16); }
__device__ __forceinline__ float bfhi(unsigned w) { return __uint_as_float(w & 0xffff0000u); }
__device__ __forceinline__ float sigm(float x) { return __builtin_amdgcn_rcpf(1.f + __builtin_amdgcn_exp2f(-x * LOG2E)); }
__device__ __forceinline__ f32x4 silu4(f32x4 x) { f32x4 r; for (int i = 0; i < 4; ++i) r[i] = x[i] * sigm(x[i]); return r; }
__device__ __forceinline__ f32x4 sigm4(f32x4 x) { f32x4 r; for (int i = 0; i < 4; ++i) r[i] = sigm(x[i]); return r; }
__device__ __forceinline__ float row_rs(const float* ssp, int row, int fq) {
    const f32x4 v = gld<f32x4>(ssp + (size_t)row * 16 + fq * 4); float s = (v[0] + v[1]) + (v[2] + v[3]);
    s += __shfl_xor(s, 16); s += __shfl_xor(s, 32);
    return __builtin_amdgcn_rsqf(s * (1.f / 1024.f) + EPS);
}


typedef __attribute__((address_space(4))) const unsigned char* kptr_t;
__device__ __forceinline__ unsigned long long ka_u64(int off) { kptr_t p = (kptr_t)__builtin_amdgcn_kernarg_segment_ptr(); asm volatile("" : "+s"(p)); return *(__attribute__((address_space(4))) const unsigned long long*)(p + off); }
__device__ __forceinline__ const float* ka_in(int k) { return (const float*)(GAS const float*)ka_u64(8 * k); }
__device__ __forceinline__ float* ka_out() { return (float*)(GAS float*)ka_u64(120); }
__device__ __forceinline__ unsigned char* ka_ws() { return (unsigned char*)(GAS unsigned char*)ka_u64(128); }

struct EpiIn {
    static constexpr bool PERM = true, AFTER_DRAIN = false;
    int L;
    struct Ld { f32x4 ss, c0, c1, s0, s1; };
    __device__ __forceinline__ void operator()(const f32x4 (&acc)[2][2][4][2], const pg8::Unit& u, int wr, int wc, int fr_, int fq_) const {
        int lane_ = fr_ + 16 * fq_; asm volatile("" : "+v"(lane_)); const int fr = lane_ & 15, fq = lane_ >> 4;
        const int pn = u.pn; unsigned char* ws = ka_ws(); float* out = ka_out();
        const float* ssp = (const float*)(ws + WS_SSP); const float* tab = (const float*)(ws + WS_TAB);
        bf16_t *Q = (bf16_t*)(ws + WS_Q), *K = (bf16_t*)(ws + WS_K), *V = (bf16_t*)(ws + WS_V), *SGA = (bf16_t*)(ws + WS_SGA), *BGC = (bf16_t*)(ws + WS_BGC), *U = (bf16_t*)(ws + WS_U);
        const bool rope = pn < 2 || (pn == 2 && wc < 2);
        const int row0 = u.pm * 256 + wr * 64 + fr, cw = wc * 32 + fq * 8;
        Ld ld[8];
#pragma unroll
        for (int it = 0; it < 10; ++it) {
            if (it < 8) {
                const int row = row0 + (it >> 2) * 128 + (it & 3) * 16;
                ld[it].ss = gld<f32x4>(ssp + (size_t)row * 16 + fq * 4);
                if (rope) { const int pidx = row < NPR ? (row & 2047) : 2048 + (row & 3); const float* tp = tab + (size_t)pidx * 64 + fq * 8;
                    ld[it].c0 = gld<f32x4>(tp); ld[it].c1 = gld<f32x4>(tp + 4); ld[it].s0 = gld<f32x4>(tp + 32); ld[it].s1 = gld<f32x4>(tp + 36); }
            }
            if (it >= 2) {
                const int k = it - 2, ai = k >> 2, m = k & 3, row = row0 + ai * 128 + m * 16;
                float sq = (ld[k].ss[0] + ld[k].ss[1]) + (ld[k].ss[2] + ld[k].ss[3]); sq += __shfl_xor(sq, 16); sq += __shfl_xor(sq, 32);
                const float rs = __builtin_amdgcn_rsqf(sq * (1.f / 1024.f) + EPS);
                const f32x4 a0 = acc[ai][0][m][0] * rs, a1 = acc[ai][0][m][1] * rs, b0 = acc[ai][1][m][0] * rs, b1 = acc[ai][1][m][1] * rs;
                if (rope) {
                    const f32x4 c0 = ld[k].c0, c1 = ld[k].c1, s0 = ld[k].s0, s1 = ld[k].s1;
                    f32x4 o1a = a0 * c0 - b0 * s0, o1b = a1 * c1 - b1 * s1, o2a = b0 * c0 + a0 * s0, o2b = b1 * c1 + a1 * s1;
                    if (pn < 2) {
                        o1a *= QS; o1b *= QS; o2a *= QS; o2b *= QS;
                        bf16_t* q = Q + (size_t)row * 512 + (4 * pn + wc) * 64 + fq * 8;
                        gst<u32x4>(q, pk8(o1a, o1b)); gst<u32x4>(q + 32, pk8(o2a, o2b));
                    } else {
                        bf16_t* kk = K + (size_t)row * 128 + wc * 64 + fq * 8;
                        gst<u32x4>(kk, pk8(o1a, o1b)); gst<u32x4>(kk + 32, pk8(o2a, o2b));
                        const bool smp = row >= NPR; const bool wr_out = smp || (row & 2047) >= 1920;
                        const size_t kofs = smp ? O_NKS + ((size_t)(L * 128 + ((row - NPR) >> 2)) * 128 + 124 + (row & 3)) * 128 : O_NKP + ((size_t)(L * 8 + (row >> 11)) * 128 + ((row & 2047) - 1920)) * 128;
                        if (wr_out) { float* ko = out + kofs + wc * 64 + fq * 8; gst<f32x4>(ko, o1a); gst<f32x4>(ko + 4, o1b); gst<f32x4>(ko + 32, o2a); gst<f32x4>(ko + 36, o2b); }
                    }
                } else if (pn == 2) {
                    bf16_t* v = V + (size_t)row * 128 + (wc - 2) * 32 + fq * 8;
                    gst<u32x4>(v, pk8(a0, a1)); gst<u32x4>(v + 64, pk8(b0, b1));
                    const bool smp = row >= NPR; const bool wr_out = smp || (row & 2047) >= 1920;
                    const size_t vofs = smp ? O_NVS + ((size_t)(L * 128 + ((row - NPR) >> 2)) * 128 + 124 + (row & 3)) * 128 : O_NVP + ((size_t)(L * 8 + (row >> 11)) * 128 + ((row & 2047) - 1920)) * 128;
                    if (wr_out) { float* vo = out + vofs + (wc - 2) * 32 + fq * 8; gst<f32x4>(vo, a0); gst<f32x4>(vo + 4, a1); gst<f32x4>(vo + 64, b0); gst<f32x4>(vo + 68, b1); }
                } else if (pn < 5) {
                    bf16_t* p = SGA + (size_t)row * 512 + (pn - 3) * 256 + cw;
                    gst<u32x4>(p, pk8(silu4(a0), silu4(a1))); gst<u32x4>(p + 128, pk8(silu4(b0), silu4(b1)));
                } else if (pn < 9) {
                    bf16_t* p = BGC + (size_t)row * 512 + (pn - 5) * 128 + cw;
                    gst<u32x4>(p, pk8(a0 * silu4(b0), a1 * silu4(b1)));
                } else {
                    const f32x4 u0 = a0 * b0, u1 = a1 * b1; const int c = (pn - 9) * 128 + cw;
                    gst<u32x4>(U + (size_t)row * 512 + c, pk8(u0, u1));
                    const bool smp = row >= NPR; const bool wr_out = smp ? (row & 3) >= 2 : (row & 2047) >= 2046;
                    const size_t uofs = smp ? O_NCS + ((size_t)(L * 128 + ((row - NPR) >> 2)) * 2 + ((row & 3) - 2)) * 512 : O_NCP + ((size_t)(L * 8 + (row >> 11)) * 2 + ((row & 2047) - 2046)) * 512;
                    if (wr_out) { float* uo = out + uofs + c; gst<f32x4>(uo, u0); gst<f32x4>(uo + 4, u1); }
                }
            }
        }
    }
};
struct EpiPP {
    static constexpr bool PERM = true, AFTER_DRAIN = false;
    int dummy;
    __device__ __forceinline__ void operator()(const f32x4 (&acc)[2][2][4][2], const pg8::Unit& u, int wr, int wc, int fr_, int fq_) const {
        int lane_ = fr_ + 16 * fq_; asm volatile("" : "+v"(lane_)); const int fr = lane_ & 15, fq = lane_ >> 4;
        bf16_t* O = (bf16_t*)(ka_ws() + WS_PP);
#pragma unroll
        for (int ai = 0; ai < 2; ++ai)
#pragma unroll
            for (int m = 0; m < 4; ++m) {
                bf16_t* p = O + (size_t)(u.pm * 256 + ai * 128 + wr * 64 + m * 16 + fr) * DM + u.pn * 256 + wc * 32 + fq * 8;
                *(u32x4*)p = pk8(acc[ai][0][m][0], acc[ai][0][m][1]); gst<u32x4>(p + 128, pk8(acc[ai][1][m][0], acc[ai][1][m][1]));
            }
    }
};
__device__ __forceinline__ f32x4 bf4(u32x2 w) { return (f32x4){bflo(w.x), bfhi(w.x), bflo(w.y), bfhi(w.y)}; }
struct EpiOut {
    static constexpr bool PERM = true, AFTER_DRAIN = false;
    int dummy;
    __device__ __forceinline__ void operator()(const f32x4 (&acc)[2][2][4][2], const pg8::Unit& u, int wr, int wc, int fr_, int fq_) const {
        int lane_ = fr_ + 16 * fq_; asm volatile("" : "+v"(lane_)); const int fr = lane_ & 15, fq = lane_ >> 4;
        unsigned char* ws = ka_ws(); const bf16_t* X0 = (const bf16_t*)(ws + WS_XB0); bf16_t* X1 = (bf16_t*)(ws + WS_XB1);
        const int row0 = u.pm * 256 + wr * 64 + fr, col0 = u.pn * 256 + wc * 32 + fq * 8;
        u32x4 xr[8][2];
#pragma unroll
        for (int it = 0; it < 10; ++it) {
            if (it < 8) { const size_t off = (size_t)(row0 + (it >> 2) * 128 + (it & 3) * 16) * DM + col0;
#pragma unroll
                for (int bj = 0; bj < 2; ++bj) xr[it][bj] = gld<u32x4>(X0 + off + bj * 128); }
            if (it >= 2) { const int k = it - 2, ai = k >> 2, m = k & 3; const size_t off = (size_t)(row0 + ai * 128 + m * 16) * DM + col0;
#pragma unroll
                for (int bj = 0; bj < 2; ++bj) { const u32x4 w = xr[k][bj];
                    gst<u32x4>(X1 + off + bj * 128, pk8(bf4((u32x2){w.x, w.y}) + acc[ai][bj][m][0], bf4((u32x2){w.z, w.w}) + acc[ai][bj][m][1])); } }
        }
    }
    __device__ __forceinline__ void small(f32x4 acc, int row, int col, int chunk) const {
        unsigned char* ws = ka_ws(); const bf16_t* X0 = (const bf16_t*)(ws + WS_XB0); bf16_t* X1 = (bf16_t*)(ws + WS_XB1);
        gst<u32x2>(X1 + (size_t)row * DM + col, pk4(bf4(gld<u32x2>(X0 + (size_t)row * DM + col)) + acc));
    }
};
struct EpiGate {
    static constexpr bool PERM = true, AFTER_DRAIN = false;
    int dummy;
    __device__ __forceinline__ void operator()(const f32x4 (&acc)[2][2][4][2], const pg8::Unit& u, int wr, int wc, int fr_, int fq_) const {
        int lane_ = fr_ + 16 * fq_; asm volatile("" : "+v"(lane_)); const int fr = lane_ & 15, fq = lane_ >> 4;
        unsigned char* ws = ka_ws(); const bf16_t* X1 = (const bf16_t*)(ws + WS_XB1); bf16_t* X0 = (bf16_t*)(ws + WS_XB0); const bf16_t* PP = (const bf16_t*)(ws + WS_PP); float* ssp = (float*)(ws + WS_SSP);
        const int row0 = u.pm * 256 + wr * 64 + fr, col0 = u.pn * 256 + wc * 32 + fq * 8;
        u32x4 xr[8][2], pr[8][2];
#pragma unroll
        for (int it = 0; it < 10; ++it) {
            if (it < 8) { const size_t off = (size_t)(row0 + (it >> 2) * 128 + (it & 3) * 16) * DM + col0;
#pragma unroll
                for (int bj = 0; bj < 2; ++bj) { xr[it][bj] = gld<u32x4>(X1 + off + bj * 128); pr[it][bj] = gld<u32x4>(PP + off + bj * 128); } }
            if (it >= 2) { const int k = it - 2, ai = k >> 2, m = k & 3, row = row0 + ai * 128 + m * 16; const size_t off = (size_t)row * DM + col0; float sq = 0.f;
#pragma unroll
                for (int bj = 0; bj < 2; ++bj) { const u32x4 xw = xr[k][bj], pw = pr[k][bj];
                    const u32x4 w = pk8(bf4((u32x2){xw.x, xw.y}) + sigm4(acc[ai][bj][m][0]) * bf4((u32x2){pw.x, pw.y}), bf4((u32x2){xw.z, xw.w}) + sigm4(acc[ai][bj][m][1]) * bf4((u32x2){pw.z, pw.w}));
                    gst<u32x4>(X0 + off + bj * 128, w);
                    const f32x4 y0 = bf4((u32x2){w.x, w.y}), y1 = bf4((u32x2){w.z, w.w});
                    sq += ((y0[0] * y0[0] + y0[1] * y0[1]) + (y0[2] * y0[2] + y0[3] * y0[3])) + ((y1[0] * y1[0] + y1[1] * y1[1]) + (y1[2] * y1[2] + y1[3] * y1[3])); }
                sq += __shfl_xor(sq, 16); sq += __shfl_xor(sq, 32);
                if (fq == 0) gst<float>(ssp + (size_t)row * 16 + u.pn * 4 + wc, sq); }
        }
    }
    __device__ __forceinline__ void small(f32x4 acc, int row, int col, int chunk) const {
        unsigned char* ws = ka_ws(); const bf16_t* X1 = (const bf16_t*)(ws + WS_XB1); bf16_t* X0 = (bf16_t*)(ws + WS_XB0); const bf16_t* PP = (const bf16_t*)(ws + WS_PP); float* ssp = (float*)(ws + WS_SSP);
        const u32x2 w = pk4(bf4(gld<u32x2>(X1 + (size_t)row * DM + col)) + sigm4(acc) * bf4(gld<u32x2>(PP + (size_t)row * DM + col))); const f32x4 x2 = bf4(w);
        gst<u32x2>(X0 + (size_t)row * DM + col, w);
        float sq = (x2[0] * x2[0] + x2[1] * x2[1]) + (x2[2] * x2[2] + x2[3] * x2[3]);
        sq += __shfl_xor(sq, 1); sq += __shfl_xor(sq, 2); sq += __shfl_xor(sq, 4); sq += __shfl_xor(sq, 8);
        if ((lane_id() & 15) == 0) gst<float>(ssp + (size_t)row * 16 + chunk, sq);
    }
};
struct FillOrder {
    int nN, nwg, c, rem, stride;
    __device__ void init(int M, int N, int G, int c_, int rem_) { nN = N / 256; nwg = (M / 256) * nN; c = c_; rem = rem_; stride = G - rem_; }
    __device__ bool next(int i, pg8::Unit& u) const { if (c < rem) return false; const int idx = (c - rem) + i * stride; if (idx >= nwg) return false; u.pm = idx / nN; u.pn = idx % nN; return true; }
    __device__ __forceinline__ void a_ready(const pg8::Unit&) const {}
    __device__ __forceinline__ void done(const pg8::Unit&) const {}
};

template <class Epi>
__device__ __forceinline__ void small_gemm(LAS unsigned char* lds, const bf16_t* A, const bf16_t* Bt, const Epi& E, const int w0) {
    int tid_ = TID_OF(w0); asm volatile("" : "+v"(tid_));
    const int tid = tid_, lane = tid & 63, wid = __builtin_amdgcn_readfirstlane(tid >> 6), fr = lane & 15, fq = lane >> 4;
    for (int tile = blockIdx.x; tile < 256; tile += gridDim.x) {
        const int rt = 2 * (tile & 7) + ((tile >> 3) & 1), ct = tile >> 4, k0 = wid * 128;
        bf16x8 af[2][4], bw[4][4];
#pragma unroll
        for (int i = 0; i < 2; ++i)
#pragma unroll
            for (int ks = 0; ks < 4; ++ks) af[i][ks] = gld<bf16x8>(A + (size_t)(rt * 32 + i * 16 + fr) * DM + k0 + ks * 32 + fq * 8);
#pragma unroll
        for (int j = 0; j < 4; ++j)
#pragma unroll
            for (int ks = 0; ks < 4; ++ks) bw[j][ks] = gld<bf16x8>(Bt + (size_t)(ct * 64 + j * 16 + fr) * DM + k0 + ks * 32 + fq * 8);
        f32x4 acc[2][4];
#pragma unroll
        for (int i = 0; i < 2; ++i)
#pragma unroll
            for (int j = 0; j < 4; ++j) { acc[i][j] = (f32x4){0.f, 0.f, 0.f, 0.f};
#pragma unroll
                for (int ks = 0; ks < 4; ++ks) acc[i][j] = __builtin_amdgcn_mfma_f32_16x16x32_bf16(bw[j][ks], af[i][ks], acc[i][j], 0, 0, 0); }
        __syncthreads();
#pragma unroll
        for (int i = 0; i < 2; ++i)
#pragma unroll
            for (int j = 0; j < 4; ++j) *(LAS f32x4*)(lds + ((wid * 8 + i * 4 + j) * 64 + lane) * 16) = acc[i][j];
        __syncthreads();
        const int row = tid >> 4, c4 = tid & 15, til = (row >> 4) * 4 + (c4 >> 2), l = (row & 15) + 16 * (c4 & 3);
        f32x4 sum = (f32x4){0.f, 0.f, 0.f, 0.f};
#pragma unroll
        for (int w = 0; w < 8; ++w) sum += *(LAS const f32x4*)(lds + ((w * 8 + til) * 64 + l) * 16);
        E.small(sum, NPR + rt * 32 + row, ct * 64 + c4 * 4, ct);
    }
    __syncthreads();
}

constexpr int KSTR = 144, VSTR = 520, VSTR_S = 328;
constexpr int VOFF = 256 * KSTR, SK_OFF = VOFF + 64 * VSTR, SV_OFF = SK_OFF + 160 * KSTR, P2_LDS_END = SV_OFF + 64 * VSTR_S;
constexpr int STG_OFF = P2_LDS_END;
static_assert(STG_OFF + 8 * 2048 <= 131072, "P2 LDS map");
typedef unsigned long long u64;
template <int VS>
__device__ __forceinline__ void attn_qk(LAS const unsigned char* Kl, const bf16x8 (&qf)[4], int kt0, int qi, int kjmin, float sink2, int lane, f32x16 (&s)[5], float& inv_l) {
    asm volatile("" : "+v"(qi), "+v"(lane));
    const int l31 = lane & 31, hi = lane >> 5;
#pragma unroll
    for (int ti = 0; ti < 5; ++ti) {
        f32x16 a = {};
#pragma unroll
        for (int c = 0; c < 4; ++c) { const bf16x8 kf = *(LAS const bf16x8*)(Kl + (32 * (kt0 + ti) + l31) * KSTR + (16 * c + 8 * hi) * 2); a = __builtin_amdgcn_mfma_f32_32x32x16_bf16(kf, qf[c], a, 0, 0, 0); }
        s[ti] = a;
    }
    float mx = sink2;
    const int kj0 = 32 * kt0 + 4 * hi, lo_ = max(qi + 1, kjmin), dA = kj0 - lo_, dB = qi + 128 - kj0;
    if (kjmin > 0) {
#pragma unroll
        for (int ti = 0; ti < 5; ++ti)
#pragma unroll
            for (int r = 0; r < 16; ++r) { const int cc = 32 * ti + (r & 3) + 8 * (r >> 2); const int mm = min(dA + cc, dB - cc);
                const float v = s[ti][r] + __int_as_float((mm >> 31) & (int)0xF149F2CAu); s[ti][r] = v; mx = fmaxf(mx, v); }
    } else {
#pragma unroll
        for (int ti = 0; ti < 5; ++ti)
#pragma unroll
            for (int r = 0; r < 16; ++r) { float v = s[ti][r];
                if (ti == 0 || ti == 4) { const int cc = 32 * ti + (r & 3) + 8 * (r >> 2); const int mm = min(dA + cc, dB - cc); v += __int_as_float((mm >> 31) & (int)0xF149F2CAu); s[ti][r] = v; }
                mx = fmaxf(mx, v); }
    }
    mx = fmaxf(mx, __shfl_xor(mx, 32));
    float l = 0.f;
#pragma unroll
    for (int ti = 0; ti < 5; ++ti)
#pragma unroll
        for (int r = 0; r < 16; ++r) { const float p = __builtin_amdgcn_exp2f(s[ti][r] - mx); s[ti][r] = p; l += p; }
    l += __shfl_xor(l, 32); l += __builtin_amdgcn_exp2f(sink2 - mx);
    inv_l = __builtin_amdgcn_rcpf(l);
}
template <int VS>
__device__ __forceinline__ void attn_pv(LAS const unsigned char* Vl, const f32x16 (&s)[5], int kt0, int lane, f32x16 (&o)[2]) {
    const int l31 = lane & 31, hi = lane >> 5;
    o[0] = (f32x16){}; o[1] = (f32x16){};
#pragma unroll
    for (int ti = 0; ti < 5; ++ti)
#pragma unroll
        for (int c2 = 0; c2 < 2; ++c2) {
            u32x4 pw; pw.x = pk2(s[ti][8 * c2 + 0], s[ti][8 * c2 + 1]); pw.y = pk2(s[ti][8 * c2 + 2], s[ti][8 * c2 + 3]); pw.z = pk2(s[ti][8 * c2 + 4], s[ti][8 * c2 + 5]); pw.w = pk2(s[ti][8 * c2 + 6], s[ti][8 * c2 + 7]);
            const bf16x8 pf = __builtin_bit_cast(bf16x8, pw);
            const int kb = 32 * (kt0 + ti) + 16 * c2 + 4 * hi;
#pragma unroll
            for (int dh = 0; dh < 2; ++dh) {
                const u64 lo = *(LAS const u64*)(Vl + (32 * dh + l31) * VS + kb * 2), hi8 = *(LAS const u64*)(Vl + (32 * dh + l31) * VS + (kb + 8) * 2);
                u32x4 vw; vw.x = (unsigned)lo; vw.y = (unsigned)(lo >> 32); vw.z = (unsigned)hi8; vw.w = (unsigned)(hi8 >> 32);
                o[dh] = __builtin_amdgcn_mfma_f32_32x32x16_bf16(__builtin_bit_cast(bf16x8, vw), pf, o[dh], 0, 0, 0);
            }
        }
}
template <int VS, bool SMP>
__device__ __forceinline__ void attn_job(LAS const unsigned char* Kl, LAS const unsigned char* Vl, LAS unsigned char* stg, const bf16_t* Q, const bf16_t* SGA, bf16_t* MIX, size_t row0, int head0, int kt0, int qi, int kjmin, float sink2, int lane) {
    const int l31 = lane & 31, hi = lane >> 5;
    const size_t qrow = SMP ? row0 + ((l31 >> 2) & 3) : row0 + l31; const int qhead = SMP ? head0 + (l31 & 3) : head0;
    bf16x8 qf[4];
#pragma unroll
    for (int c = 0; c < 4; ++c) { qf[c] = gld<bf16x8>(Q + qrow * 512 + qhead * 64 + 16 * c + 8 * hi); if (SMP && l31 >= 16) qf[c] = (bf16x8){0, 0, 0, 0, 0, 0, 0, 0}; }
    f32x16 s[5], o[2]; float inv_l;
    attn_qk<VS>(Kl, qf, kt0, qi, kjmin, sink2, lane, s, inv_l);
    const int ch = lane & 3; size_t grow[2]; int gcol[2]; u32x4 g[2][2];
#pragma unroll
    for (int i = 0; i < 2; ++i) { const int rr = (lane >> 2) + 16 * i;
        grow[i] = SMP ? row0 + (rr >> 2) : row0 + rr; gcol[i] = (SMP ? head0 + (rr & 3) : head0) * 64 + 8 * ch;
#pragma unroll
        for (int dh = 0; dh < 2; ++dh) g[i][dh] = (SMP && i == 1) ? (u32x4){0u, 0u, 0u, 0u} : gld<u32x4>(SGA + grow[i] * 512 + gcol[i] + 32 * dh); }
    attn_pv<VS>(Vl, s, kt0, lane, o);
    const int fq = (l31 >> 1) & 3;
#pragma unroll
    for (int dh = 0; dh < 2; ++dh) {
#pragma unroll
        for (int r4 = 0; r4 < 4; ++r4) { f32x4 v; v[0] = o[dh][4 * r4 + 0] * inv_l; v[1] = o[dh][4 * r4 + 1] * inv_l; v[2] = o[dh][4 * r4 + 2] * inv_l; v[3] = o[dh][4 * r4 + 3] * inv_l;
            *(LAS u32x2*)(stg + l31 * 64 + ((r4 ^ fq) * 16) + 8 * hi) = pk4(v); }
        asm volatile("s_waitcnt lgkmcnt(0)" ::: "memory");
#pragma unroll
        for (int i = 0; i < 2; ++i) { if (SMP && i == 1) continue;
            const int rr = (lane >> 2) + 16 * i; const u32x4 w = *(LAS const u32x4*)(stg + rr * 64 + ((ch ^ ((rr >> 1) & 3)) * 16)); const u32x4 gg = g[i][dh];
            u32x4 r; r.x = pk2(bflo(w.x) * bflo(gg.x), bfhi(w.x) * bfhi(gg.x)); r.y = pk2(bflo(w.y) * bflo(gg.y), bfhi(w.y) * bfhi(gg.y)); r.z = pk2(bflo(w.z) * bflo(gg.z), bfhi(w.z) * bfhi(gg.z)); r.w = pk2(bflo(w.w) * bflo(gg.w), bfhi(w.w) * bfhi(gg.w));
            gst<u32x4>(MIX + grow[i] * 1024 + gcol[i] + 32 * dh, r); }
        asm volatile("s_waitcnt lgkmcnt(0)" ::: "memory");
    }
}
__device__ __forceinline__ void unpack8(u32x4 w, float (&f)[8]) { f[0] = bflo(w.x); f[1] = bfhi(w.x); f[2] = bflo(w.y); f[3] = bfhi(w.y); f[4] = bflo(w.z); f[5] = bfhi(w.z); f[6] = bflo(w.w); f[7] = bfhi(w.w); }
template <int NT>
__device__ __forceinline__ void conv_rows(const bf16_t* U, const bf16_t* BGC, bf16_t* MIX, const float* cw, size_t row0, int c0, float (&p2v)[8], float (&p1v)[8]) {
    float w0[8], w1[8], w2[8];
#pragma unroll
    for (int e = 0; e < 8; ++e) { w0[e] = gld<float>(cw + e); w1[e] = gld<float>(cw + 512 + e); w2[e] = gld<float>(cw + 1024 + e); }
    u32x4 ur[NT], br[NT];
#pragma unroll
    for (int i = 0; i < NT; ++i) { ur[i] = gld<u32x4>(U + (row0 + i) * 512 + c0); br[i] = gld<u32x4>(BGC + (row0 + i) * 512 + c0); }
#pragma unroll
    for (int i = 0; i < NT; ++i) {
        float uc[8], bg[8], y[8]; unpack8(ur[i], uc); unpack8(br[i], bg);
#pragma unroll
        for (int e = 0; e < 8; ++e) { y[e] = bg[e] * (w0[e] * p2v[e] + w1[e] * p1v[e] + w2[e] * uc[e]); p2v[e] = p1v[e]; p1v[e] = uc[e]; }
        u32x4 w; w.x = pk2(y[0], y[1]); w.y = pk2(y[2], y[3]); w.z = pk2(y[4], y[5]); w.w = pk2(y[6], y[7]);
        gst<u32x4>(MIX + (row0 + i) * 1024 + 512 + c0, w);
    }
}

struct P2Args { const bf16_t *Q, *K, *V, *SGA, *BGC, *U; bf16_t* MIX; const float *cache_k, *cache_v, *state, *sinks, *conv_w; float* out; };
__device__ __forceinline__ P2Args p2_args() { unsigned char* ws = ka_ws(); return P2Args{(const bf16_t*)(ws + WS_Q), (const bf16_t*)(ws + WS_K), (const bf16_t*)(ws + WS_V), (const bf16_t*)(ws + WS_SGA), (const bf16_t*)(ws + WS_BGC), (const bf16_t*)(ws + WS_U), (bf16_t*)(ws + WS_MIX), ka_in(2), ka_in(3), ka_in(4), ka_in(9), ka_in(10), ka_out()}; }
__device__ __forceinline__ void p2_phase(LAS unsigned char* lds, const int L, const int w0) {
    int tid_ = TID_OF(w0); asm volatile("" : "+v"(tid_));
    const int wid = __builtin_amdgcn_readfirstlane(tid_ >> 6);
#define P2_RELAUNDER() int tid = tid_; asm volatile("" : "+v"(tid)); const int lane = tid & 63, l31 = lane & 31; (void)l31; (void)lane
    LAS unsigned short* vt = (LAS unsigned short*)(lds + VOFF); LAS unsigned short* svt = (LAS unsigned short*)(lds + SV_OFF);
    for (int item = blockIdx.x; item < 256; item += gridDim.x) {
        const P2Args A = p2_args();
        const int xj = item & 7, xx = item >> 3, b = xj, n = xx >> 1, kvh = xx & 1, sb = 16 * xj + (xx >> 1);
        const size_t cb = ((size_t)(L * 128 + sb) * 128) * 128 + kvh * 64;
        __syncthreads();
        {
            P2_RELAUNDER();
            u32x4 kv[4], vv[4]; f32x4 kq[4], vq[4];
#pragma unroll
            for (int it = 0; it < 4; ++it) {
                const int idx = it * 512 + tid, kj = idx >> 3, ch = idx & 7, kp = 128 * (n - 1) + kj;
                kv[it] = (u32x4){0u, 0u, 0u, 0u}; vv[it] = (u32x4){0u, 0u, 0u, 0u};
                if (kp >= 0) { const size_t r = (size_t)(b * 2048 + kp); kv[it] = gld<u32x4>(A.K + r * 128 + kvh * 64 + ch * 8); vv[it] = gld<u32x4>(A.V + r * 128 + kvh * 64 + ch * 8); }
                const int j = idx >> 4, c16 = idx & 15;
                kq[it] = gld_nt<f32x4>(A.cache_k + cb + (size_t)j * 128 + c16 * 4); vq[it] = gld_nt<f32x4>(A.cache_v + cb + (size_t)j * 128 + c16 * 4);
            }
#pragma unroll
            for (int it = 0; it < 4; ++it) {
                const int idx = it * 512 + tid, kj = idx >> 3, ch = idx & 7;
                *(LAS u32x4*)(lds + kj * KSTR + ch * 16) = kv[it];
#pragma unroll
                for (int e = 0; e < 8; ++e) { const unsigned w = vv[it][e >> 1]; vt[(ch * 8 + e) * (VSTR / 2) + kj] = (unsigned short)((e & 1) ? (w >> 16) : (w & 0xffffu)); }
                const int j = idx >> 4, c16 = idx & 15;
                *(LAS u32x2*)(lds + SK_OFF + j * KSTR + c16 * 8) = pk4(kq[it]);
                const u32x2 vw = pk4(vq[it]);
                svt[(c16 * 4 + 0) * (VSTR_S / 2) + j] = (unsigned short)(vw.x & 0xffffu); svt[(c16 * 4 + 1) * (VSTR_S / 2) + j] = (unsigned short)(vw.x >> 16);
                svt[(c16 * 4 + 2) * (VSTR_S / 2) + j] = (unsigned short)(vw.y & 0xffffu); svt[(c16 * 4 + 3) * (VSTR_S / 2) + j] = (unsigned short)(vw.y >> 16);
                if (j >= 4) { gst_nt<f32x4>(A.out + O_NKS + cb + (size_t)(j - 4) * 128 + c16 * 4, kq[it]); gst_nt<f32x4>(A.out + O_NVS + cb + (size_t)(j - 4) * 128 + c16 * 4, vq[it]); }
            }
            if (tid < 32) {
                const int t = tid >> 3, ch = tid & 7; const size_t r = (size_t)(NPR + 4 * sb + t);
                const u32x4 k4 = gld<u32x4>(A.K + r * 128 + kvh * 64 + ch * 8), v4 = gld<u32x4>(A.V + r * 128 + kvh * 64 + ch * 8);
                *(LAS u32x4*)(lds + SK_OFF + (128 + t) * KSTR + ch * 16) = k4;
#pragma unroll
                for (int e = 0; e < 8; ++e) { const unsigned w = v4[e >> 1]; svt[(ch * 8 + e) * (VSTR_S / 2) + 128 + t] = (unsigned short)((e & 1) ? (w >> 16) : (w & 0xffffu)); }
            }
            { unsigned z = 0u; asm volatile("" : "+v"(z));
              if (tid < 252) *(LAS u32x4*)(lds + SK_OFF + 132 * KSTR + tid * 16) = (u32x4){z, z, z, z};
              if (tid < 448) { const int d = tid / 7, q = tid % 7; *(LAS u32x2*)(lds + SV_OFF + d * VSTR_S + 264 + q * 8) = (u32x2){z, z}; } }
        }
        __syncthreads();
        {
            P2_RELAUNDER();
            const int head = 4 * kvh + (wid >> 1); const float sink2 = gld<float>(A.sinks + L * 8 + head) * LOG2E;
#pragma unroll 1
            for (int aa = 0; aa < 2; ++aa) {
                const int a = 2 * (wid & 1) + aa; const size_t row0 = (size_t)(b * 2048 + 128 * n + 32 * a);
                attn_job<VSTR, false>(lds, lds + VOFF, lds + STG_OFF + wid * 2048, A.Q, A.SGA, A.MIX, row0, head, a, 32 * a + l31, n == 0 ? 128 : 0, sink2, lane);
            }
        }
        if (wid == 0) {
            P2_RELAUNDER();
            const int t = (l31 >> 2) & 3, head = 4 * kvh + (l31 & 3); const float sink2 = gld<float>(A.sinks + L * 8 + head) * LOG2E;
            attn_job<VSTR_S, true>(lds + SK_OFF, lds + SV_OFF, lds + STG_OFF, A.Q, A.SGA, A.MIX, (size_t)(NPR + 4 * sb), 4 * kvh, 0, t, 0, sink2, lane);
        } else {
            P2_RELAUNDER();
            const int hw = (wid - 1) * 2 + (lane >> 5), c0 = 256 * kvh + 8 * l31; const float* cw = A.conv_w + (size_t)L * 3 * 512 + c0;
#pragma unroll 1
            for (int un = hw; un < 17; un += 14) {
                float p2v[8], p1v[8];
                if (un < 16) {
                    const int t0 = 128 * n + 8 * un; const size_t rb = (size_t)b * 2048;
#pragma unroll
                    for (int e = 0; e < 8; ++e) { p2v[e] = 0.f; p1v[e] = 0.f; }
                    if (t0 >= 2) { unpack8(gld<u32x4>(A.U + (rb + t0 - 2) * 512 + c0), p2v); unpack8(gld<u32x4>(A.U + (rb + t0 - 1) * 512 + c0), p1v); }
                    conv_rows<8>(A.U, A.BGC, A.MIX, cw, rb + t0, c0, p2v, p1v);
                } else {
                    const float* st = A.state + ((size_t)(L * 128 + sb) * 2) * 512 + c0;
#pragma unroll
                    for (int e = 0; e < 8; ++e) { p2v[e] = gld<float>(st + e); p1v[e] = gld<float>(st + 512 + e); }
                    conv_rows<4>(A.U, A.BGC, A.MIX, cw, (size_t)(NPR + 4 * sb), c0, p2v, p1v);
                }
            }
        }
    }
    __syncthreads();
#undef P2_RELAUNDER
}

__device__ __forceinline__ float wave_sum(float v) {
#pragma unroll
    for (int o = 1; o < 64; o <<= 1) v += __shfl_xor(v, o);
    return v;
}
__device__ __forceinline__ int win_src_col(int nb) {
    const int pn = nb >> 3, q = nb & 7, bj = q >> 2, wc = q & 3;
    if (pn < 2) return (4 * pn + wc) * 64 + 32 * bj;
    if (pn == 2) return wc < 2 ? 512 + wc * 64 + 32 * bj : 640 + 64 * bj + (wc - 2) * 32;
    if (pn < 5) return 768 + (pn - 3) * 256 + q * 32;
    if (pn < 9) return (bj == 0 ? 1280 : 2816) + 128 * (pn - 5) + wc * 32;
    return (bj == 0 ? 1792 : 2304) + 128 * (pn - 9) + wc * 32;
}
__device__ __forceinline__ void tr_item64(const float* W, int N, int K, int src_a, int src_b, const float* g, bf16_t* WT, int dst_row0, int k0, LAS float* scr, int lane) {
    const int sc = (lane < 32 ? src_a : src_b) + (lane & 31);
    float v[64];
#pragma unroll
    for (int kk = 0; kk < 64; ++kk) v[kk] = gld_nt<float>(W + (size_t)(k0 + kk) * N + sc);
#pragma unroll
    for (int kk = 0; kk < 64; ++kk) scr[kk * 65 + lane] = g ? v[kk] * gld<float>(g + k0 + kk) : v[kk];
    asm volatile("s_waitcnt lgkmcnt(0)" ::: "memory");
    const int c = lane & 7;
#pragma unroll
    for (int j = 0; j < 8; ++j) { const int n = (lane >> 3) + 8 * j; const LAS float* sp = scr + (8 * c) * 65 + n;
        u32x4 o; o.x = pk2(sp[0 * 65], sp[1 * 65]); o.y = pk2(sp[2 * 65], sp[3 * 65]); o.z = pk2(sp[4 * 65], sp[5 * 65]); o.w = pk2(sp[6 * 65], sp[7 * 65]);
        gst<u32x4>(WT + (size_t)(dst_row0 + n) * K + k0 + 8 * c, o); }
    asm volatile("s_waitcnt lgkmcnt(0)" ::: "memory");
}
struct Args { const float* in[15]; float* out; unsigned char* ws; int ph_lo, ph_hi; };
__device__ __forceinline__ void p0_phase(LAS unsigned char* lds, const Args& a, const int w0) {
    const int tid = TID_OF(w0), lane = tid & 63, wid = __builtin_amdgcn_readfirstlane(tid >> 6);
    const int gw = blockIdx.x * 8 + wid, NGW = gridDim.x * 8;
    LAS float* scr = (LAS float*)(lds + wid * 16640);
    unsigned char* ws = a.ws;
    constexpr int I_IN = DEPTH * 52 * 16, I_SQ = DEPTH * 16 * 16, I_PP = DEPTH * 16 * 4;
    for (int it = gw; it < I_IN + 2 * I_SQ + I_PP; it += NGW) {
        int r = it;
        if (r < I_IN) { const int L = r / (52 * 16), q = r % (52 * 16), nb = q % 52, kb = q / 52;
            tr_item64(a.in[8] + (size_t)L * DM * INW, INW, DM, win_src_col(2 * nb), win_src_col(2 * nb + 1), a.in[7] + L * DM, (bf16_t*)(ws + WS_WIN) + (size_t)L * INW * DM, nb * 64, kb * 64, scr, lane); continue; }
        r -= I_IN;
        if (r < 2 * I_SQ) { const int which = r / I_SQ; r %= I_SQ; const int L = r / 256, q = r % 256, nb = q & 15, kb = q >> 4;
            tr_item64(a.in[which ? 12 : 11] + (size_t)L * DM * DM, DM, DM, nb * 64, nb * 64 + 32, nullptr, (bf16_t*)(ws + (which ? WS_WPG : WS_WOUT)) + (size_t)L * DM * DM, nb * 64, kb * 64, scr, lane); continue; }
        r -= 2 * I_SQ;
        { const int L = r / 64, q = r % 64, nb = q & 15, kb = q >> 4;
            tr_item64(a.in[13] + (size_t)L * PLE * DM, DM, PLE, nb * 64, nb * 64 + 32, nullptr, (bf16_t*)(ws + WS_WPP) + (size_t)L * DM * PLE, nb * 64, kb * 64, scr, lane); }
    }
    for (int row = gw; row < MR; row += 2 * NGW) {
        const int row1 = row + NGW; const bool has1 = row1 < MR; const int r1 = has1 ? row1 : row;
        const float* xr0 = row < NPR ? a.in[0] + (size_t)row * DM : a.in[1] + (size_t)(row - NPR) * DM;
        const float* xr1 = r1 < NPR ? a.in[0] + (size_t)r1 * DM : a.in[1] + (size_t)(r1 - NPR) * DM;
        f32x4 v0[4], v1[4];
#pragma unroll
        for (int j = 0; j < 4; ++j) { v0[j] = gld_nt<f32x4>(xr0 + 4 * lane + 256 * j); v1[j] = gld_nt<f32x4>(xr1 + 4 * lane + 256 * j); }
        float s0 = 0.f, s1 = 0.f;
        bf16_t* xb0 = (bf16_t*)(ws + WS_XB0) + (size_t)row * DM; bf16_t* xb1 = (bf16_t*)(ws + WS_XB0) + (size_t)r1 * DM;
#pragma unroll
        for (int j = 0; j < 4; ++j) { s0 += (v0[j][0] * v0[j][0] + v0[j][1] * v0[j][1]) + (v0[j][2] * v0[j][2] + v0[j][3] * v0[j][3]); s1 += (v1[j][0] * v1[j][0] + v1[j][1] * v1[j][1]) + (v1[j][2] * v1[j][2] + v1[j][3] * v1[j][3]);
            *(u32x2*)(xb0 + 4 * lane + 256 * j) = pk4(v0[j]); if (has1) *(u32x2*)(xb1 + 4 * lane + 256 * j) = pk4(v1[j]); }
        s0 = wave_sum(s0); s1 = wave_sum(s1);
        if (lane < 16) { ((float*)(ws + WS_SSP))[(size_t)row * 16 + lane] = lane == 0 ? s0 : 0.f; if (has1) ((float*)(ws + WS_SSP))[(size_t)row1 * 16 + lane] = lane == 0 ? s1 : 0.f; }
    }
    const int gt = blockIdx.x * 512 + tid, GT = gridDim.x * 512;
    for (int i = gt; i < DEPTH * MR * 64; i += 4 * GT) {
        f32x4 v[4];
#pragma unroll
        for (int j = 0; j < 4; ++j) { const int ii = i + j * GT; const int ic = ii < DEPTH * MR * 64 ? ii : i; const int L = ic / (MR * 64), q = ic % (MR * 64), row = q >> 6, c4 = q & 63;
            const float* src = row < NPR ? a.in[5] + ((size_t)L * NPR + row) * PLE : a.in[6] + ((size_t)L * NSR + row - NPR) * PLE; v[j] = gld_nt<f32x4>(src + c4 * 4); }
#pragma unroll
        for (int j = 0; j < 4; ++j) { const int ii = i + j * GT; if (ii < DEPTH * MR * 64) *(u32x2*)((bf16_t*)(ws + WS_PB) + (size_t)ii * 4) = pk4(v[j]); }
    }
    for (int i = gt; i < 2052 * 32; i += GT) {
        const int pidx = i >> 5, d = i & 31; const double pos = pidx < 2048 ? (double)pidx : (double)(8192 + pidx - 2048);
        double inv = 1.0; for (int k = 0; k < d; ++k) inv *= 0.74989420933245582730;
        double rev = pos * inv * 0.15915494309189533577; rev -= __builtin_floor(rev);
        const float f = (float)rev; float* tp = (float*)(ws + WS_TAB) + (size_t)pidx * 64 + d;
        tp[0] = __builtin_amdgcn_cosf(f); tp[32] = __builtin_amdgcn_sinf(f);
    }
}
__device__ __forceinline__ void final_phase(const int w0) {
    int tid_ = TID_OF(w0); asm volatile("" : "+v"(tid_)); const int tid = tid_, lane = tid & 63, wid = tid >> 6; const int gw = blockIdx.x * 8 + wid, NGW = gridDim.x * 8;
    unsigned char* ws = ka_ws(); const float* ssp = (const float*)(ws + WS_SSP); const bf16_t* X0 = (const bf16_t*)(ws + WS_XB0); const float* gf = ka_in(14); float* outp = ka_out();
    f32x4 g[4];
#pragma unroll
    for (int j = 0; j < 4; ++j) g[j] = gld<f32x4>(gf + 4 * lane + 256 * j);
    for (int row = gw; row < MR; row += 2 * NGW) {
        const int row1 = row + NGW; const bool has1 = row1 < MR; const int r1 = has1 ? row1 : row;
        float s0 = lane < 16 ? gld<float>(ssp + (size_t)row * 16 + lane) : 0.f, s1 = lane < 16 ? gld<float>(ssp + (size_t)r1 * 16 + lane) : 0.f;
        u32x2 v0[4], v1[4];
#pragma unroll
        for (int j = 0; j < 4; ++j) { v0[j] = gld<u32x2>(X0 + (size_t)row * DM + 4 * lane + 256 * j); v1[j] = gld<u32x2>(X0 + (size_t)r1 * DM + 4 * lane + 256 * j); }
        s0 = wave_sum(s0); s1 = wave_sum(s1);
        const float rs0 = __builtin_amdgcn_rsqf(s0 * (1.f / 1024.f) + EPS), rs1 = __builtin_amdgcn_rsqf(s1 * (1.f / 1024.f) + EPS);
#pragma unroll
        for (int j = 0; j < 4; ++j) { gst_nt<f32x4>(outp + (size_t)row * DM + 4 * lane + 256 * j, bf4(v0[j]) * rs0 * g[j]); if (has1) gst_nt<f32x4>(outp + (size_t)row1 * DM + 4 * lane + 256 * j, bf4(v1[j]) * rs1 * g[j]); }
    }
}

#define RLX_AGENT __ATOMIC_RELAXED, __HIP_MEMORY_SCOPE_AGENT
#define XB_TMO      128
#define XB_XCNT(j)  (256  + 64 * (j))
#define XB_XSUB(j)  (1280 + 64 * (j))
#define XB_XGEN(j)  (2304 + 64 * (j))
#define XB_TOP      3328
#define XB_TOPGEN   3392
#define XCD_BAR_WORDS 3456
#define XB_SPIN_CAP (1u << 18)

__device__ __forceinline__ unsigned xb_ld(unsigned* p)              { return __hip_atomic_load((GAS unsigned*)p, __ATOMIC_RELAXED, __HIP_MEMORY_SCOPE_AGENT); }
__device__ __forceinline__ unsigned xb_add(unsigned* p, unsigned v) { return __hip_atomic_fetch_add((GAS unsigned*)p, v, __ATOMIC_RELAXED, __HIP_MEMORY_SCOPE_AGENT); }
__device__ __forceinline__ unsigned xb_xcc_id() { return (unsigned)__builtin_amdgcn_s_getreg((3 << 11) | 20) & 0xFu; }
#define XB_SPIN(cond, bar) do { unsigned _sp = 0; while (cond) { __builtin_amdgcn_s_sleep(1); \
    if ((++_sp & 255u) == 0u) { if (xb_ld(&(bar)[XB_TMO])) break; if (_sp > XB_SPIN_CAP) { atomicAdd(&(bar)[XB_TMO], 1u); break; } } } } while (0)

struct XcdBarrier {
    unsigned* bar; unsigned x; int w0;
    volatile LAS unsigned* st;
};

__device__ __forceinline__ XcdBarrier xcd_barrier_post(unsigned* bar, volatile LAS unsigned* st, int w0) {
    XcdBarrier b; b.bar = bar; b.x = xb_xcc_id(); b.st = st; b.w0 = w0;
    if (TID_OF(w0) == 0) (void)xb_add(&bar[XB_XCNT(b.x)], 1u);
    return b;
}
__device__ __forceinline__ void xcd_barrier_complete(unsigned* bar, unsigned x, unsigned& nloc, unsigned& nx) {
    const unsigned G = gridDim.x * gridDim.y * gridDim.z;
    unsigned sum, cnt, mine, sp = 0u;
    for (;;) {
        sum = 0u; cnt = 0u; mine = 0u;
#pragma unroll
        for (unsigned j = 0; j < 16; ++j) { const unsigned c = xb_ld(&bar[XB_XCNT(j)]); sum += c; cnt += (c > 0u) ? 1u : 0u; mine = (j == x) ? c : mine; }
        if (sum == G) break;
        __builtin_amdgcn_s_sleep(1);
        if ((++sp & 255u) == 0u) { if (xb_ld(&bar[XB_TMO])) break; if (sp > XB_SPIN_CAP) { atomicAdd(&bar[XB_TMO], 1u); break; } }
    }
    nloc = mine > 0u ? mine : 1u; nx = cnt > 0u ? cnt : 1u;
}

__device__ __forceinline__ void xcd_barrier(const XcdBarrier& b) {
    asm volatile("s_waitcnt vmcnt(0)" ::: "memory");
    __syncthreads();
    if (TID_OF(b.w0) == 0) {
        unsigned* bar = b.bar; unsigned bx = b.x; asm volatile("" : "+s"(bar), "+s"(bx));
        __builtin_amdgcn_s_waitcnt(0);
        unsigned nloc = b.st[0], nx = b.st[1];
        if (nloc == 0u) { xcd_barrier_complete(bar, bx, nloc, nx); b.st[0] = nloc; b.st[1] = nx; }
        const unsigned old = xb_add(&bar[XB_XSUB(bx)], 1u);
        const unsigned gen = old / nloc;
        if (old + 1u == (gen + 1u) * nloc) {
            __builtin_amdgcn_fence(__ATOMIC_RELEASE, "agent");
            asm volatile("s_waitcnt vmcnt(0)" ::: "memory");
            const unsigned og = xb_add(&bar[XB_TOP], 1u);
            const unsigned tg = og / nx;
            if (og + 1u == (tg + 1u) * nx) xb_add(&bar[XB_TOPGEN], 1u);
            else XB_SPIN(xb_ld(&bar[XB_TOPGEN]) == tg, bar);
            __builtin_amdgcn_fence(__ATOMIC_ACQUIRE, "agent");
            xb_add(&bar[XB_XGEN(bx)], 1u);
            asm volatile("s_waitcnt vmcnt(0)" ::: "memory");
        } else {
            XB_SPIN(xb_ld(&bar[XB_XGEN(bx)]) == gen, bar);
            __builtin_amdgcn_fence(__ATOMIC_ACQUIRE, "agent");
            asm volatile("s_waitcnt vmcnt(0)" ::: "memory");
        }
    }
    __syncthreads();
}

#ifndef MK_SPLIT
#define MK_SPLIT 0
#endif
__device__ __forceinline__ unsigned char* opq(unsigned char* p) { asm volatile("" : "+s"(p)); return p; }
__global__ void __launch_bounds__(512, 2) fwd(Args a) {
    extern __shared__ __attribute__((aligned(16))) unsigned char lds_raw[];
    LAS unsigned char* lds = (LAS unsigned char*)lds_raw;
    cg::grid_group grid = cg::this_grid();
    volatile LAS unsigned* misc = (volatile LAS unsigned*)(lds + 139264);
    if (a.ph_hi == 0x7fffffff) grid.sync();
    const int w0 = __builtin_amdgcn_readfirstlane((int)threadIdx.x >> 6);
    if (TID_OF(w0) < 16) misc[TID_OF(w0)] = 0u;
    __syncthreads();
    const XcdBarrier bar = xcd_barrier_post((unsigned*)(a.ws + WS_BAR), misc, w0);
    const int G = gridDim.x, c = blockIdx.x;
#if MK_SPLIT
    const int lo = a.ph_lo, hi = a.ph_hi;
#define IN(k) (lo <= (k) && (k) < hi)
#define SEAM(k) do { if (IN(k) && IN((k) + 1)) grid.sync(); } while (0)
#else
#define IN(k) true
#define SEAM(k) xcd_barrier(bar)
#endif
#ifndef DIS_P0
    if (IN(0)) p0_phase(lds, a, w0);
#endif
    SEAM(0);
#pragma unroll 1
    for (int L = 0; L < DEPTH; ++L) {
        const int ph = 1 + 4 * L;
        if (IN(ph)) {
            int cp_ = c; asm volatile("" : "+s"(cp_)); const bool pp_first = ((cp_ >> 3) & 1) != 0;
#pragma unroll 1
            for (int step = 0; step < 2; ++step) {
                if ((step == 0) != pp_first) {
                    unsigned char* ws = ka_ws();
                    pg8::Gemm g{(const bf16_t*)(ws + WS_XB0), (const bf16_t*)(ws + WS_WIN) + (size_t)L * INW * DM, MR, INW, DM}; int c1_ = c; asm volatile("" : "+s"(c1_)); pg8::StaticOrder S; S.init(MR, INW, G, c1_);
                    EpiIn E{L};
                    pg8::gemm_phase<EpiIn, pg8::StaticOrder, true, true>(lds, g, S, E, w0);
                } else {
                    unsigned char* ws = ka_ws();
                    pg8::Gemm g{(const bf16_t*)(ws + WS_PB) + (size_t)L * MR * PLE, (const bf16_t*)(ws + WS_WPP) + (size_t)L * DM * PLE, MR, DM, PLE};
                    const int nu = (MR / 256) * (INW / 256); int c2_ = c; asm volatile("" : "+s"(c2_)); FillOrder S; S.init(MR, DM, G, c2_, nu % G);
                    EpiPP E{0};
                    pg8::gemm_phase<EpiPP, FillOrder, true, true>(lds, g, S, E, w0);
                }
            }
        }
        SEAM(ph);
        if (IN(ph + 1)) {
#ifndef DIS_P2
            unsigned char* ws = ka_ws();
            p2_phase(lds, L, w0);
#endif
        }
        SEAM(ph + 1);
        if (IN(ph + 2)) {
#ifndef DIS_P3A
            unsigned char* ws = ka_ws();
            pg8::Gemm g{(const bf16_t*)(ws + WS_MIX), (const bf16_t*)(ws + WS_WOUT) + (size_t)L * DM * DM, NPR, DM, DM}; pg8::StaticOrder S; S.init(NPR, DM, G, c);
            EpiOut E{0};
            int cb_ = c; asm volatile("" : "+s"(cb_)); const bool small_first = ((cb_ >> 3) & 1) == 0;
#pragma unroll 1
            for (int step = 0; step < 2; ++step) {
                if ((step == 0) == small_first) small_gemm<EpiOut>(lds, g.A + (size_t)NPR * DM, g.Bt, E, w0);
                else pg8::gemm_phase<EpiOut, pg8::StaticOrder, true, true>(lds, g, S, E, w0);
            }
#endif
        }
        SEAM(ph + 2);
        if (IN(ph + 3)) {
#ifndef DIS_P3B
            unsigned char* ws = ka_ws();
            pg8::Gemm g{(const bf16_t*)(ws + WS_XB1), (const bf16_t*)(ws + WS_WPG) + (size_t)L * DM * DM, NPR, DM, DM}; pg8::StaticOrder S; S.init(NPR, DM, G, c);
            EpiGate E{0};
            int cb_ = c; asm volatile("" : "+s"(cb_)); const bool small_first = ((cb_ >> 3) & 1) == 0;
#pragma unroll 1
            for (int step = 0; step < 2; ++step) {
                if ((step == 0) == small_first) small_gemm<EpiGate>(lds, g.A + (size_t)NPR * DM, g.Bt, E, w0);
                else pg8::gemm_phase<EpiGate, pg8::StaticOrder, true, true>(lds, g, S, E, w0);
            }
#endif
        }
        SEAM(ph + 3);
    }
    if (IN(17)) final_phase(w0);
#undef IN
#undef SEAM
}

extern "C" void kernel_launch(void* const* d_in, const int* in_sizes, int n_in, void* d_out, int out_size, void* d_ws, size_t ws_size, hipStream_t stream) {
    static int grid = 0;
    if (grid == 0) {
        if (n_in != 15 || (size_t)out_size != O_END || ws_size < WS_END) { fprintf(stderr, "kernel_launch: unexpected shapes (n_in %d out %d ws %zu)\n", n_in, out_size, ws_size); grid = -1; return; }
        int dev = 0, cus = 0, per = 0;
        if (hipGetDevice(&dev) != hipSuccess || hipDeviceGetAttribute(&cus, hipDeviceAttributeMultiprocessorCount, dev) != hipSuccess) { grid = -1; return; }
        if (hipFuncSetAttribute((const void*)fwd, hipFuncAttributeMaxDynamicSharedMemorySize, LDS_BYTES) != hipSuccess) { fprintf(stderr, "kernel_launch: hipFuncSetAttribute failed\n"); grid = -1; return; }
        if (hipOccupancyMaxActiveBlocksPerMultiprocessor(&per, (const void*)fwd, 512, LDS_BYTES) != hipSuccess || per < 1) { fprintf(stderr, "kernel_launch: occupancy query %d\n", per); per = 1; }
        (void)hipGetLastError();
        grid = cus;
        fprintf(stderr, "kernel_launch: grid %d (cus %d x per_cu %d), ws %zu\n", grid, cus, per, ws_size);
    }
    if (grid < 0) return;
    if (hipMemsetAsync((char*)d_ws + WS_BAR, 0, 16384, stream) != hipSuccess) { fprintf(stderr, "kernel_launch: memset failed\n"); return; }
    Args a{};
    for (int i = 0; i < 15; ++i) a.in[i] = (const float*)d_in[i];
    a.out = (float*)d_out; a.ws = (unsigned char*)d_ws;
#if MK_SPLIT
    for (int ph = 0; ph < 18; ++ph) { a.ph_lo = ph; a.ph_hi = ph + 1; hipLaunchKernelGGL(fwd, dim3(grid), dim3(512), LDS_BYTES, stream, a); }
#else
    a.ph_lo = 0; a.ph_hi = 18;
    void* args[] = {&a};
    const hipError_t e = hipLaunchCooperativeKernel((const void*)fwd, dim3(grid), dim3(512), args, LDS_BYTES, stream);
    if (e != hipSuccess) fprintf(stderr, "kernel_launch: cooperative launch failed: %s (grid %d)\n", hipGetErrorString(e), grid);
#endif
}
```

```cpp
#include <hip/hip_runtime.h>
#include <hip/hip_cooperative_groups.h>
#include <cstdio>
#include <cstdint>
namespace cg = cooperative_groups;
__device__ __forceinline__ int lane_id() { int l; asm volatile("v_mbcnt_lo_u32_b32 %0, -1, 0\n\tv_mbcnt_hi_u32_b32 %0, -1, %0" : "=v"(l)); return l; }
#define TID_OF(w0) ((w0) * 64 + lane_id())
namespace pg8 {
#define PG8_LAS __attribute__((address_space(3)))
typedef unsigned short bf16_t;
typedef short bf16x8 __attribute__((ext_vector_type(8)));
typedef float f32x4 __attribute__((ext_vector_type(4)));
typedef unsigned u32x4 __attribute__((ext_vector_type(4)));
constexpr int BM = 256, BK = 64, HALF = 128, HTB = HALF * BK * 2  , STAGE_BYTES = 8 * HTB, NXCD = 8, WGM = 8;

__host__ __device__ __forceinline__ int lds_byte(int r, int c) { const int st = (r >> 4) * 2 + (c >> 5), rr = r & 15, cc = c & 31, ob = rr * 64 + cc * 2; return st * 1024 + (ob ^ (((ob >> 9) & 1) << 5)); }
__host__ __device__ __forceinline__ void stage_rc(int b, int& R, int& C) { const int st = b / 1024, sb = b % 1024, swz = sb ^ (((sb >> 9) & 1) << 5); R = (st >> 1) * 16 + swz / 64; C = (st & 1) * 32 + (swz % 64) / 2; }
__host__ __device__ __forceinline__ int perm32(int rho) { const int n = rho >> 4, i = rho & 15; return 8 * (i >> 2) + 4 * n + (i & 3); }

struct Unit { int pm, pn; };
struct Gemm { const bf16_t* A; const bf16_t* Bt; int M, N, K; };

struct StaticOrder {
    int nM, nN, nwg, G, c;
    __host__ __device__ void init(int M, int N, int G_, int c_) { nM = M / BM; nN = N / BM; nwg = nM * nN; G = G_; c = c_; }
    __host__ __device__ bool next(int i, Unit& u) const {
        const long L = (long)i * G + c; if (L >= nwg) return false;
        int wgid = (int)L; { const int q = nwg / NXCD, r = nwg % NXCD, xcd = wgid % NXCD, off = wgid / NXCD; wgid = (xcd < r ? xcd * (q + 1) : r * (q + 1) + (xcd - r) * q) + off; }
        const int nig = WGM * nN, gid = wgid / nig, fm = gid * WGM, gsz = (nM - fm) < WGM ? (nM - fm) : WGM;
        u.pm = fm + ((wgid % nig) % gsz); u.pn = (wgid % nig) / gsz; return true;
    }
    __device__ __forceinline__ void a_ready(const Unit&) const {}
    __device__ __forceinline__ void done(const Unit&) const {}
};

__device__ __forceinline__ unsigned cvt_pk_bf16(float lo, float hi) { unsigned r; asm volatile("v_cvt_pk_bf16_f32 %0, %1, %2" : "=v"(r) : "v"(lo), "v"(hi)); return r; }
typedef float f32x2 __attribute__((ext_vector_type(2)));
template <class Epi, class Sched, bool ALIGN_EPI = false, bool SP2 = false>
__device__ __forceinline__ void gemm_phase(PG8_LAS unsigned char* lds, const Gemm g, const Sched& S, const Epi& E, const int w0) {
    int tid_ = TID_OF(w0); asm volatile("" : "+v"(tid_));
    const int tid = tid_, wid = __builtin_amdgcn_readfirstlane(tid >> 6), lane = tid & 63, wr = wid >> 2, wc = wid & 3, fr = lane & 15, fq = lane >> 4;
    const int K = g.K, nt = K / BK;
    unsigned voffA[2], voffB[2];
#pragma unroll
    for (int i = 0; i < 2; ++i) { int R, C; stage_rc(tid * 16 + i * 8192, R, C); const int Rb = Epi::PERM ? ((R & ~31) + perm32(R & 31)) : R;
        voffA[i] = (unsigned)(R * K + C) * 2u; voffB[i] = (unsigned)(Rb * K + C) * 2u; }
    const size_t kstep = (size_t)(BK * 2);
    const size_t hstep = (size_t)HALF * K * 2;
    const size_t tstep = 2 * hstep;
    const unsigned ldsw = (unsigned)wid * 1024u;
    const int aoff = lds_byte(wr * 64 + fr, fq * 8), boff = lds_byte(wc * 32 + fr, fq * 8);
#define PG8_SA(b, h) (((b) * 2 + (h)) * HTB)
#define PG8_SB(b, h) ((4 + (b) * 2 + (h)) * HTB)
#define PG8_STAGE(bufoff, gbase, voff) do { _Pragma("unroll") for (int _i = 0; _i < 2; ++_i) \
        __builtin_amdgcn_global_load_lds((const unsigned*)((const char*)(gbase) + (voff)[_i]), (PG8_LAS unsigned*)(lds + (bufoff) + ldsw + _i * 8192), 16, 0, 0); } while (0)
#define PG8_LDA(dst, b, h) do { _Pragma("unroll") for (int m = 0; m < 4; ++m) _Pragma("unroll") for (int k = 0; k < 2; ++k) dst[m][k] = *(const PG8_LAS bf16x8*)(lds + PG8_SA(b, h) + aoff + m * 2048 + k * 1024); } while (0)
#define PG8_LDB(dst, b, h) do { _Pragma("unroll") for (int n = 0; n < 2; ++n) _Pragma("unroll") for (int k = 0; k < 2; ++k) dst[n][k] = *(const PG8_LAS bf16x8*)(lds + PG8_SB(b, h) + boff + n * 2048 + k * 1024); } while (0)
#define PG8_MMA(ai, bj, At, Bt) do { __builtin_amdgcn_s_setprio(1); _Pragma("unroll") for (int m = 0; m < 4; ++m) _Pragma("unroll") for (int n = 0; n < 2; ++n) _Pragma("unroll") for (int k = 0; k < 2; ++k) \
        acc[ai][bj][m][n] = __builtin_amdgcn_mfma_f32_16x16x32_bf16(Bt[n][k], At[m][k], acc[ai][bj][m][n], 0, 0, 0); __builtin_amdgcn_s_setprio(0); } while (0)
#define PG8_WAIT_V(n) asm volatile("s_waitcnt vmcnt(" #n ")" ::: "memory")
#define PG8_WAIT_L(n) asm volatile("s_waitcnt lgkmcnt(" #n ")" ::: "memory")
#define PG8_BAR __builtin_amdgcn_s_barrier()
#define PG8_SCHED __builtin_amdgcn_sched_barrier(0)
    Unit cur, nxt; int ui = 0;
    if (!S.next(0, cur)) return;
    f32x4 acc[2][2][4][2];
#pragma unroll
    for (int a = 0; a < 2; ++a)
#pragma unroll
        for (int b = 0; b < 2; ++b)
#pragma unroll
            for (int m = 0; m < 4; ++m)
#pragma unroll
                for (int n = 0; n < 2; ++n) acc[a][b][m][n] = (f32x4){0.f, 0.f, 0.f, 0.f};
    bf16x8 At[4][2], B0[2][2], B1[2][2];
    const char* cA = (const char*)g.A + (size_t)cur.pm * tstep; const char* cB = (const char*)g.Bt + (size_t)cur.pn * tstep;
    S.a_ready(cur);
    if constexpr (SP2) {
        PG8_STAGE(PG8_SB(0, 0), cB, voffB); PG8_STAGE(PG8_SB(0, 1), cB + hstep, voffB); PG8_STAGE(PG8_SA(0, 0), cA, voffA); PG8_STAGE(PG8_SA(0, 1), cA + hstep, voffA);
        if (wr == 1) PG8_BAR;
        PG8_WAIT_V(2); PG8_BAR;
        PG8_STAGE(PG8_SB(1, 0), cB + kstep, voffB); PG8_STAGE(PG8_SA(1, 0), cA + kstep, voffA); PG8_STAGE(PG8_SB(1, 1), cB + hstep + kstep, voffB);
        PG8_WAIT_V(6); PG8_BAR;
    } else {
        PG8_STAGE(PG8_SB(0, 0), cB, voffB); PG8_STAGE(PG8_SA(0, 0), cA, voffA); PG8_STAGE(PG8_SB(0, 1), cB + hstep, voffB); PG8_STAGE(PG8_SA(0, 1), cA + hstep, voffA);
        if (wr == 1) PG8_BAR;
        PG8_WAIT_V(4); PG8_BAR;
        PG8_STAGE(PG8_SB(1, 0), cB + kstep, voffB); PG8_STAGE(PG8_SA(1, 0), cA + kstep, voffA); PG8_STAGE(PG8_SB(1, 1), cB + hstep + kstep, voffB);
        PG8_WAIT_V(6); PG8_BAR;
    }
    for (;;) {
        const bool has_next = S.next(ui + 1, nxt);
        const char* nA = has_next ? (const char*)g.A + (size_t)nxt.pm * tstep : cA; const char* nB = has_next ? (const char*)g.Bt + (size_t)nxt.pn * tstep : cB;
#pragma unroll 1
        for (int t = 0; t < nt; t += 2) {
            const bool last = (t == nt - 2);
            const char* a1 = cA + (size_t)(t + 1) * kstep;
            const char* a2 = last ? nA : cA + (size_t)(t + 2) * kstep; const char* b2 = last ? nB : cB + (size_t)(t + 2) * kstep;
            const char* a3 = a2 + kstep; const char* b3 = b2 + kstep;
            if (last && has_next) S.a_ready(nxt);
            if constexpr (SP2) {
            PG8_LDB(B0, 0, 0); PG8_LDB(B1, 0, 1); PG8_SCHED; PG8_LDA(At, 0, 0); PG8_STAGE(PG8_SA(1, 1), a1 + hstep, voffA);
            PG8_WAIT_V(8); PG8_WAIT_L(0); PG8_BAR; PG8_MMA(0, 0, At, B0); PG8_MMA(0, 1, At, B1); PG8_BAR; PG8_SCHED;
            PG8_LDA(At, 0, 1); PG8_STAGE(PG8_SB(0, 0), b2, voffB); PG8_STAGE(PG8_SB(0, 1), b2 + hstep, voffB); PG8_STAGE(PG8_SA(0, 0), a2, voffA);
            PG8_WAIT_V(8); PG8_WAIT_L(0); PG8_BAR; PG8_MMA(1, 0, At, B0); PG8_MMA(1, 1, At, B1); PG8_BAR; PG8_SCHED;
            PG8_LDB(B0, 1, 0); PG8_LDB(B1, 1, 1); PG8_SCHED; PG8_LDA(At, 1, 0); PG8_STAGE(PG8_SA(0, 1), a2 + hstep, voffA);
            PG8_WAIT_V(8); PG8_WAIT_L(0); PG8_BAR; PG8_MMA(0, 0, At, B0); PG8_MMA(0, 1, At, B1); PG8_BAR; PG8_SCHED;
            PG8_LDA(At, 1, 1); PG8_STAGE(PG8_SB(1, 0), b3, voffB); PG8_STAGE(PG8_SB(1, 1), b3 + hstep, voffB); PG8_STAGE(PG8_SA(1, 0), a3, voffA);
            PG8_WAIT_V(8); PG8_WAIT_L(0); PG8_BAR; PG8_MMA(1, 0, At, B0); PG8_MMA(1, 1, At, B1); PG8_BAR; PG8_SCHED;
            } else {
            PG8_LDB(B0, 0, 0); PG8_SCHED; PG8_LDA(At, 0, 0); PG8_STAGE(PG8_SA(1, 1), a1 + hstep, voffA);
            PG8_WAIT_L(8); PG8_BAR; PG8_WAIT_L(0); PG8_MMA(0, 0, At, B0); PG8_BAR; PG8_SCHED;
            PG8_LDB(B1, 0, 1); PG8_STAGE(PG8_SB(0, 0), b2, voffB);
            PG8_BAR; PG8_WAIT_L(0); PG8_MMA(0, 1, At, B1); PG8_BAR;
            PG8_LDA(At, 0, 1); PG8_STAGE(PG8_SA(0, 0), a2, voffA);
            PG8_BAR; PG8_WAIT_L(0); PG8_MMA(1, 0, At, B0); PG8_BAR; PG8_SCHED;
            PG8_STAGE(PG8_SB(0, 1), b2 + hstep, voffB);
            PG8_WAIT_V(6); PG8_BAR; PG8_MMA(1, 1, At, B1); PG8_BAR;
            PG8_LDB(B0, 1, 0); PG8_SCHED; PG8_LDA(At, 1, 0); PG8_STAGE(PG8_SA(0, 1), a2 + hstep, voffA);
            PG8_WAIT_L(8); PG8_BAR; PG8_WAIT_L(0); PG8_MMA(0, 0, At, B0); PG8_BAR; PG8_SCHED;
            PG8_LDB(B1, 1, 1); PG8_STAGE(PG8_SB(1, 0), b3, voffB);
            PG8_BAR; PG8_WAIT_L(0); PG8_MMA(0, 1, At, B1); PG8_BAR;
            PG8_LDA(At, 1, 1); PG8_STAGE(PG8_SA(1, 0), a3, voffA);
            PG8_BAR; PG8_WAIT_L(0); PG8_MMA(1, 0, At, B0); PG8_BAR; PG8_SCHED;
            PG8_STAGE(PG8_SB(1, 1), b3 + hstep, voffB);
            PG8_WAIT_V(6); PG8_BAR; PG8_MMA(1, 1, At, B1); PG8_BAR;
            }
        }
        if constexpr (ALIGN_EPI) { if (wr == 0) PG8_BAR; }
        if constexpr (!Epi::AFTER_DRAIN) { E(acc, cur, wr, wc, fr, fq); S.done(cur); }
        if (!has_next) break;
#pragma unroll
        for (int a = 0; a < 2; ++a)
#pragma unroll
            for (int b = 0; b < 2; ++b)
#pragma unroll
                for (int m = 0; m < 4; ++m)
#pragma unroll
                    for (int n = 0; n < 2; ++n) acc[a][b][m][n] = (f32x4){0.f, 0.f, 0.f, 0.f};
        cur = nxt; cA = nA; cB = nB; ++ui;
        if constexpr (ALIGN_EPI) { if (wr == 1) PG8_BAR; }
    }
    PG8_WAIT_V(0);
    if constexpr (!ALIGN_EPI) { if (wr == 0) PG8_BAR; }
    PG8_BAR;
    if constexpr (Epi::AFTER_DRAIN) { E.fused(acc, cur, wr, wc, fr, fq, lds, wid, lane); S.done(cur); }
#undef PG8_SA
#undef PG8_SB
#undef PG8_STAGE
#undef PG8_LDA
#undef PG8_LDB
#undef PG8_MMA
#undef PG8_WAIT_V
#undef PG8_WAIT_L
#undef PG8_BAR
#undef PG8_SCHED
}
}

#define GAS __attribute__((address_space(1)))
#define LAS __attribute__((address_space(3)))
using pg8::bf16_t; using pg8::bf16x8; using pg8::f32x4; using pg8::u32x4;
typedef unsigned u32x2 __attribute__((ext_vector_type(2)));
typedef float f32x16 __attribute__((ext_vector_type(16)));
constexpr int DM = 1024, NPR = 16384, NSR = 512, MR = NPR + NSR, DEPTH = 4, INW = 3328, PLE = 256;
constexpr float EPS = 1e-6f, LOG2E = 1.4426950408889634f, QS = 0.125f * 1.4426950408889634f;
constexpr size_t O_NKP = 17301504, O_NVP = 17825792, O_NCP = 18350080, O_NKS = 18382848, O_NVS = 26771456, O_NCS = 35160064, O_END = 35684352;
constexpr size_t MiB = 1u << 20;
constexpr size_t WS_SSP = 0  , WS_TAB = 253 * MiB  , WS_WIN = 2 * MiB, WS_WOUT = 28 * MiB, WS_WPG = 36 * MiB, WS_WPP = 44 * MiB, WS_XB0 = 46 * MiB, WS_PB = 79 * MiB, WS_PP = 112 * MiB,
                 WS_MIX = 145 * MiB, WS_Q = 178 * MiB, WS_SGA = WS_Q + 16 * MiB + MiB / 2, WS_XB1 = WS_Q, WS_BGC = 211 * MiB, WS_U = WS_BGC + 16 * MiB + MiB / 2, WS_K = 244 * MiB,
                 WS_V = WS_K + 4 * MiB + MiB / 8, WS_BAR = 254 * MiB  , WS_END = 255 * MiB;
static_assert(WS_V + 4 * MiB + MiB / 8 <= WS_TAB && WS_TAB + 2052 * 64 * 4 <= WS_BAR && (size_t)MR * 16 * 4 <= 2 * MiB && WS_END <= 256 * MiB, "ws map");
constexpr int LDS_BYTES = 147456;
template <class T, class P> __device__ __forceinline__ T gld(P p) { return *(GAS const T*)p; }
template <class T, class P> __device__ __forceinline__ void gst(P p, T v) { *(GAS T*)p = v; }
template <class T, class P> __device__ __forceinline__ void gst_nt(P p, T v) { __builtin_nontemporal_store(v, (GAS T*)p); }
template <class T, class P> __device__ __forceinline__ T gld_nt(P p) { return __builtin_nontemporal_load((GAS const T*)p); }

__device__ __forceinline__ unsigned pk2(float lo, float hi) { return pg8::cvt_pk_bf16(lo, hi); }
__device__ __forceinline__ u32x4 pk8(f32x4 a, f32x4 b) { u32x4 w; w.x = pk2(a[0], a[1]); w.y = pk2(a[2], a[3]); w.z = pk2(b[0], b[1]); w.w = pk2(b[2], b[3]); return w; }
__device__ __forceinline__ u32x2 pk4(f32x4 a) { u32x2 w; w.x = pk2(a[0], a[1]); w.y = pk2(a[2], a[3]); return w; }
__device__ __forceinline__ float bflo(unsigned w) { return __uint_as_float(w << 16); }
__device__ __forceinline__ float bfhi(unsigned w) { return __uint_as_float(w & 0xffff0000u); }
__device__ __forceinline__ float sigm(float x) { return __builtin_amdgcn_rcpf(1.f + __builtin_amdgcn_exp2f(-x * LOG2E)); }
__device__ __forceinline__ f32x4 silu4(f32x4 x) { f32x4 r; for (int i = 0; i < 4; ++i) r[i] = x[i] * sigm(x[i]); return r; }
__device__ __forceinline__ f32x4 sigm4(f32x4 x) { f32x4 r; for (int i = 0; i < 4; ++i) r[i] = sigm(x[i]); return r; }
__device__ __forceinline__ float row_rs(const float* ssp, int row, int fq) {
    const f32x4 v = gld<f32x4>(ssp + (size_t)row * 16 + fq * 4); float s = (v[0] + v[1]) + (v[2] + v[3]);
    s += __shfl_xor(s, 16); s += __shfl_xor(s, 32);
    return __builtin_amdgcn_rsqf(s * (1.f / 1024.f) + EPS);
}


typedef __attribute__((address_space(4))) const unsigned char* kptr_t;
__device__ __forceinline__ unsigned long long ka_u64(int off) { kptr_t p = (kptr_t)__builtin_amdgcn_kernarg_segment_ptr(); asm volatile("" : "+s"(p)); return *(__attribute__((address_space(4))) const unsigned long long*)(p + off); }
__device__ __forceinline__ const float* ka_in(int k) { return (const float*)(GAS const float*)ka_u64(8 * k); }
__device__ __forceinline__ float* ka_out() { return (float*)(GAS float*)ka_u64(120); }
__device__ __forceinline__ unsigned char* ka_ws() { return (unsigned char*)(GAS unsigned char*)ka_u64(128); }

struct EpiIn {
    static constexpr bool PERM = true, AFTER_DRAIN = false;
    int L;
    struct Ld { f32x4 ss, c0, c1, s0, s1; };
    __device__ __forceinline__ void operator()(const f32x4 (&acc)[2][2][4][2], const pg8::Unit& u, int wr, int wc, int fr_, int fq_) const {
        int lane_ = fr_ + 16 * fq_; asm volatile("" : "+v"(lane_)); const int fr = lane_ & 15, fq = lane_ >> 4;
        const int pn = u.pn; unsigned char* ws = ka_ws(); float* out = ka_out();
        const float* ssp = (const float*)(ws + WS_SSP); const float* tab = (const float*)(ws + WS_TAB);
        bf16_t *Q = (bf16_t*)(ws + WS_Q), *K = (bf16_t*)(ws + WS_K), *V = (bf16_t*)(ws + WS_V), *SGA = (bf16_t*)(ws + WS_SGA), *BGC = (bf16_t*)(ws + WS_BGC), *U = (bf16_t*)(ws + WS_U);
        const bool rope = pn < 2 || (pn == 2 && wc < 2);
        const int row0 = u.pm * 256 + wr * 64 + fr, cw = wc * 32 + fq * 8;
        Ld ld[8];
#pragma unroll
        for (int it = 0; it < 10; ++it) {
            if (it < 8) {
                const int row = row0 + (it >> 2) * 128 + (it & 3) * 16;
                ld[it].ss = gld<f32x4>(ssp + (size_t)row * 16 + fq * 4);
                if (rope) { const int pidx = row < NPR ? (row & 2047) : 2048 + (row & 3); const float* tp = tab + (size_t)pidx * 64 + fq * 8;
                    ld[it].c0 = gld<f32x4>(tp); ld[it].c1 = gld<f32x4>(tp + 4); ld[it].s0 = gld<f32x4>(tp + 32); ld[it].s1 = gld<f32x4>(tp + 36); }
            }
            if (it >= 2) {
                const int k = it - 2, ai = k >> 2, m = k & 3, row = row0 + ai * 128 + m * 16;
                float sq = (ld[k].ss[0] + ld[k].ss[1]) + (ld[k].ss[2] + ld[k].ss[3]); sq += __shfl_xor(sq, 16); sq += __shfl_xor(sq, 32);
                const float rs = __builtin_amdgcn_rsqf(sq * (1.f / 1024.f) + EPS);
                const f32x4 a0 = acc[ai][0][m][0] * rs, a1 = acc[ai][0][m][1] * rs, b0 = acc[ai][1][m][0] * rs, b1 = acc[ai][1][m][1] * rs;
                if (rope) {
                    const f32x4 c0 = ld[k].c0, c1 = ld[k].c1, s0 = ld[k].s0, s1 = ld[k].s1;
                    f32x4 o1a = a0 * c0 - b0 * s0, o1b = a1 * c1 - b1 * s1, o2a = b0 * c0 + a0 * s0, o2b = b1 * c1 + a1 * s1;
                    if (pn < 2) {
                        o1a *= QS; o1b *= QS; o2a *= QS; o2b *= QS;
                        bf16_t* q = Q + (size_t)row * 512 + (4 * pn + wc) * 64 + fq * 8;
                        gst<u32x4>(q, pk8(o1a, o1b)); gst<u32x4>(q + 32, pk8(o2a, o2b));
                    } else {
                        bf16_t* kk = K + (size_t)row * 128 + wc * 64 + fq * 8;
                        gst<u32x4>(kk, pk8(o1a, o1b)); gst<u32x4>(kk + 32, pk8(o2a, o2b));
                        const bool smp = row >= NPR; const bool wr_out = smp || (row & 2047) >= 1920;
                        const size_t kofs = smp ? O_NKS + ((size_t)(L * 128 + ((row - NPR) >> 2)) * 128 + 124 + (row & 3)) * 128 : O_NKP + ((size_t)(L * 8 + (row >> 11)) * 128 + ((row & 2047) - 1920)) * 128;
                        if (wr_out) { float* ko = out + kofs + wc * 64 + fq * 8; gst<f32x4>(ko, o1a); gst<f32x4>(ko + 4, o1b); gst<f32x4>(ko + 32, o2a); gst<f32x4>(ko + 36, o2b); }
                    }
                } else if (pn == 2) {
                    bf16_t* v = V + (size_t)row * 128 + (wc - 2) * 32 + fq * 8;
                    gst<u32x4>(v, pk8(a0, a1)); gst<u32x4>(v + 64, pk8(b0, b1));
                    const bool smp = row >= NPR; const bool wr_out = smp || (row & 2047) >= 1920;
                    const size_t vofs = smp ? O_NVS + ((size_t)(L * 128 + ((row - NPR) >> 2)) * 128 + 124 + (row & 3)) * 128 : O_NVP + ((size_t)(L * 8 + (row >> 11)) * 128 + ((row & 2047) - 1920)) * 128;
                    if (wr_out) { float* vo = out + vofs + (wc - 2) * 32 + fq * 8; gst<f32x4>(vo, a0); gst<f32x4>(vo + 4, a1); gst<f32x4>(vo + 64, b0); gst<f32x4>(vo + 68, b1); }
                } else if (pn < 5) {
                    bf16_t* p = SGA + (size_t)row * 512 + (pn - 3) * 256 + cw;
                    gst<u32x4>(p, pk8(silu4(a0), silu4(a1))); gst<u32x4>(p + 128, pk8(silu4(b0), silu4(b1)));
                } else if (pn < 9) {
                    bf16_t* p = BGC + (size_t)row * 512 + (pn - 5) * 128 + cw;
                    gst<u32x4>(p, pk8(a0 * silu4(b0), a1 * silu4(b1)));
                } else {
                    const f32x4 u0 = a0 * b0, u1 = a1 * b1; const int c = (pn - 9) * 128 + cw;
                    gst<u32x4>(U + (size_t)row * 512 + c, pk8(u0, u1));
                    const bool smp = row >= NPR; const bool wr_out = smp ? (row & 3) >= 2 : (row & 2047) >= 2046;
                    const size_t uofs = smp ? O_NCS + ((size_t)(L * 128 + ((row - NPR) >> 2)) * 2 + ((row & 3) - 2)) * 512 : O_NCP + ((size_t)(L * 8 + (row >> 11)) * 2 + ((row & 2047) - 2046)) * 512;
                    if (wr_out) { float* uo = out + uofs + c; gst<f32x4>(uo, u0); gst<f32x4>(uo + 4, u1); }
                }
            }
        }
    }
};
struct EpiPP {
    static constexpr bool PERM = true, AFTER_DRAIN = false;
    int dummy;
    __device__ __forceinline__ void operator()(const f32x4 (&acc)[2][2][4][2], const pg8::Unit& u, int wr, int wc, int fr_, int fq_) const {
        int lane_ = fr_ + 16 * fq_; asm volatile("" : "+v"(lane_)); const int fr = lane_ & 15, fq = lane_ >> 4;
        bf16_t* O = (bf16_t*)(ka_ws() + WS_PP);
#pragma unroll
        for (int ai = 0; ai < 2; ++ai)
#pragma unroll
            for (int m = 0; m < 4; ++m) {
                bf16_t* p = O + (size_t)(u.pm * 256 + ai * 128 + wr * 64 + m * 16 + fr) * DM + u.pn * 256 + wc * 32 + fq * 8;
                *(u32x4*)p = pk8(acc[ai][0][m][0], acc[ai][0][m][1]); gst<u32x4>(p + 128, pk8(acc[ai][1][m][0], acc[ai][1][m][1]));
            }
    }
};
__device__ __forceinline__ f32x4 bf4(u32x2 w) { return (f32x4){bflo(w.x), bfhi(w.x), bflo(w.y), bfhi(w.y)}; }
struct EpiOut {
    static constexpr bool PERM = true, AFTER_DRAIN = false;
    int dummy;
    __device__ __forceinline__ void operator()(const f32x4 (&acc)[2][2][4][2], const pg8::Unit& u, int wr, int wc, int fr_, int fq_) const {
        int lane_ = fr_ + 16 * fq_; asm volatile("" : "+v"(lane_)); const int fr = lane_ & 15, fq = lane_ >> 4;
        unsigned char* ws = ka_ws(); const bf16_t* X0 = (const bf16_t*)(ws + WS_XB0); bf16_t* X1 = (bf16_t*)(ws + WS_XB1);
        const int row0 = u.pm * 256 + wr * 64 + fr, col0 = u.pn * 256 + wc * 32 + fq * 8;
        u32x4 xr[8][2];
#pragma unroll
        for (int it = 0; it < 10; ++it) {
            if (it < 8) { const size_t off = (size_t)(row0 + (it >> 2) * 128 + (it & 3) * 16) * DM + col0;
#pragma unroll
                for (int bj = 0; bj < 2; ++bj) xr[it][bj] = gld<u32x4>(X0 + off + bj * 128); }
            if (it >= 2) { const int k = it - 2, ai = k >> 2, m = k & 3; const size_t off = (size_t)(row0 + ai * 128 + m * 16) * DM + col0;
#pragma unroll
                for (int bj = 0; bj < 2; ++bj) { const u32x4 w = xr[k][bj];
                    gst<u32x4>(X1 + off + bj * 128, pk8(bf4((u32x2){w.x, w.y}) + acc[ai][bj][m][0], bf4((u32x2){w.z, w.w}) + acc[ai][bj][m][1])); } }
        }
    }
    __device__ __forceinline__ void small(f32x4 acc, int row, int col, int chunk) const {
        unsigned char* ws = ka_ws(); const bf16_t* X0 = (const bf16_t*)(ws + WS_XB0); bf16_t* X1 = (bf16_t*)(ws + WS_XB1);
        gst<u32x2>(X1 + (size_t)row * DM + col, pk4(bf4(gld<u32x2>(X0 + (size_t)row * DM + col)) + acc));
    }
};
struct EpiGate {
    static constexpr bool PERM = true, AFTER_DRAIN = false;
    int dummy;
    __device__ __forceinline__ void operator()(const f32x4 (&acc)[2][2][4][2], const pg8::Unit& u, int wr, int wc, int fr_, int fq_) const {
        int lane_ = fr_ + 16 * fq_; asm volatile("" : "+v"(lane_)); const int fr = lane_ & 15, fq = lane_ >> 4;
        unsigned char* ws = ka_ws(); const bf16_t* X1 = (const bf16_t*)(ws + WS_XB1); bf16_t* X0 = (bf16_t*)(ws + WS_XB0); const bf16_t* PP = (const bf16_t*)(ws + WS_PP); float* ssp = (float*)(ws + WS_SSP);
        const int row0 = u.pm * 256 + wr * 64 + fr, col0 = u.pn * 256 + wc * 32 + fq * 8;
        u32x4 xr[8][2], pr[8][2];
#pragma unroll
        for (int it = 0; it < 10; ++it) {
            if (it < 8) { const size_t off = (size_t)(row0 + (it >> 2) * 128 + (it & 3) * 16) * DM + col0;
#pragma unroll
                for (int bj = 0; bj < 2; ++bj) { xr[it][bj] = gld<u32x4>(X1 + off + bj * 128); pr[it][bj] = gld<u32x4>(PP + off + bj * 128); } }
            if (it >= 2) { const int k = it - 2, ai = k >> 2, m = k & 3, row = row0 + ai * 128 + m * 16; const size_t off = (size_t)row * DM + col0; float sq = 0.f;
#pragma unroll
                for (int bj = 0; bj < 2; ++bj) { const u32x4 xw = xr[k][bj], pw = pr[k][bj];
                    const u32x4 w = pk8(bf4((u32x2){xw.x, xw.y}) + sigm4(acc[ai][bj][m][0]) * bf4((u32x2){pw.x, pw.y}), bf4((u32x2){xw.z, xw.w}) + sigm4(acc[ai][bj][m][1]) * bf4((u32x2){pw.z, pw.w}));
                    gst<u32x4>(X0 + off + bj * 128, w);
                    const f32x4 y0 = bf4((u32x2){w.x, w.y}), y1 = bf4((u32x2){w.z, w.w});
                    sq += ((y0[0] * y0[0] + y0[1] * y0[1]) + (y0[2] * y0[2] + y0[3] * y0[3])) + ((y1[0] * y1[0] + y1[1] * y1[1]) + (y1[2] * y1[2] + y1[3] * y1[3])); }
                sq += __shfl_xor(sq, 16); sq += __shfl_xor(sq, 32);
                if (fq == 0) gst<float>(ssp + (size_t)row * 16 + u.pn * 4 + wc, sq); }
        }
    }
    __device__ __forceinline__ void small(f32x4 acc, int row, int col, int chunk) const {
        unsigned char* ws = ka_ws(); const bf16_t* X1 = (const bf16_t*)(ws + WS_XB1); bf16_t* X0 = (bf16_t*)(ws + WS_XB0); const bf16_t* PP = (const bf16_t*)(ws + WS_PP); float* ssp = (float*)(ws + WS_SSP);
        const u32x2 w = pk4(bf4(gld<u32x2>(X1 + (size_t)row * DM + col)) + sigm4(acc) * bf4(gld<u32x2>(PP + (size_t)row * DM + col))); const f32x4 x2 = bf4(w);
        gst<u32x2>(X0 + (size_t)row * DM + col, w);
        float sq = (x2[0] * x2[0] + x2[1] * x2[1]) + (x2[2] * x2[2] + x2[3] * x2[3]);
        sq += __shfl_xor(sq, 1); sq += __shfl_xor(sq, 2); sq += __shfl_xor(sq, 4); sq += __shfl_xor(sq, 8);
        if ((lane_id() & 15) == 0) gst<float>(ssp + (size_t)row * 16 + chunk, sq);
    }
};
struct FillOrder {
    int nN, nwg, c, rem, stride;
    __device__ void init(int M, int N, int G, int c_, int rem_) { nN = N / 256; nwg = (M / 256) * nN; c = c_; rem = rem_; stride = G - rem_; }
    __device__ bool next(int i, pg8::Unit& u) const { if (c < rem) return false; const int idx = (c - rem) + i * stride; if (idx >= nwg) return false; u.pm = idx / nN; u.pn = idx % nN; return true; }
    __device__ __forceinline__ void a_ready(const pg8::Unit&) const {}
    __device__ __forceinline__ void done(const pg8::Unit&) const {}
};

template <class Epi>
__device__ __forceinline__ void small_gemm(LAS unsigned char* lds, const bf16_t* A, const bf16_t* Bt, const Epi& E, const int w0) {
    int tid_ = TID_OF(w0); asm volatile("" : "+v"(tid_));
    const int tid = tid_, lane = tid & 63, wid = __builtin_amdgcn_readfirstlane(tid >> 6), fr = lane & 15, fq = lane >> 4;
    for (int tile = blockIdx.x; tile < 256; tile += gridDim.x) {
        const int rt = 2 * (tile & 7) + ((tile >> 3) & 1), ct = tile >> 4, k0 = wid * 128;
        bf16x8 af[2][4], bw[4][4];
#pragma unroll
        for (int i = 0; i < 2; ++i)
#pragma unroll
            for (int ks = 0; ks < 4; ++ks) af[i][ks] = gld<bf16x8>(A + (size_t)(rt * 32 + i * 16 + fr) * DM + k0 + ks * 32 + fq * 8);
#pragma unroll
        for (int j = 0; j < 4; ++j)
#pragma unroll
            for (int ks = 0; ks < 4; ++ks) bw[j][ks] = gld<bf16x8>(Bt + (size_t)(ct * 64 + j * 16 + fr) * DM + k0 + ks * 32 + fq * 8);
        f32x4 acc[2][4];
#pragma unroll
        for (int i = 0; i < 2; ++i)
#pragma unroll
            for (int j = 0; j < 4; ++j) { acc[i][j] = (f32x4){0.f, 0.f, 0.f, 0.f};
#pragma unroll
                for (int ks = 0; ks < 4; ++ks) acc[i][j] = __builtin_amdgcn_mfma_f32_16x16x32_bf16(bw[j][ks], af[i][ks], acc[i][j], 0, 0, 0); }
        __syncthreads();
#pragma unroll
        for (int i = 0; i < 2; ++i)
#pragma unroll
            for (int j = 0; j < 4; ++j) *(LAS f32x4*)(lds + ((wid * 8 + i * 4 + j) * 64 + lane) * 16) = acc[i][j];
        __syncthreads();
        const int row = tid >> 4, c4 = tid & 15, til = (row >> 4) * 4 + (c4 >> 2), l = (row & 15) + 16 * (c4 & 3);
        f32x4 sum = (f32x4){0.f, 0.f, 0.f, 0.f};
#pragma unroll
        for (int w = 0; w < 8; ++w) sum += *(LAS const f32x4*)(lds + ((w * 8 + til) * 64 + l) * 16);
        E.small(sum, NPR + rt * 32 + row, ct * 64 + c4 * 4, ct);
    }
    __syncthreads();
}

constexpr int KSTR = 144, VSTR = 520, VSTR_S = 328;
constexpr int VOFF = 256 * KSTR, SK_OFF = VOFF + 64 * VSTR, SV_OFF = SK_OFF + 160 * KSTR, P2_LDS_END = SV_OFF + 64 * VSTR_S;
constexpr int STG_OFF = P2_LDS_END;
static_assert(STG_OFF + 8 * 2048 <= 131072, "P2 LDS map");
typedef unsigned long long u64;
template <int VS>
__device__ __forceinline__ void attn_qk(LAS const unsigned char* Kl, const bf16x8 (&qf)[4], int kt0, int qi, int kjmin, float sink2, int lane, f32x16 (&s)[5], float& inv_l) {
    asm volatile("" : "+v"(qi), "+v"(lane));
    const int l31 = lane & 31, hi = lane >> 5;
#pragma unroll
    for (int ti = 0; ti < 5; ++ti) {
        f32x16 a = {};
#pragma unroll
        for (int c = 0; c < 4; ++c) { const bf16x8 kf = *(LAS const bf16x8*)(Kl + (32 * (kt0 + ti) + l31) * KSTR + (16 * c + 8 * hi) * 2); a = __builtin_amdgcn_mfma_f32_32x32x16_bf16(kf, qf[c], a, 0, 0, 0); }
        s[ti] = a;
    }
    float mx = sink2;
    const int kj0 = 32 * kt0 + 4 * hi, lo_ = max(qi + 1, kjmin), dA = kj0 - lo_, dB = qi + 128 - kj0;
    if (kjmin > 0) {
#pragma unroll
        for (int ti = 0; ti < 5; ++ti)
#pragma unroll
            for (int r = 0; r < 16; ++r) { const int cc = 32 * ti + (r & 3) + 8 * (r >> 2); const int mm = min(dA + cc, dB - cc);
                const float v = s[ti][r] + __int_as_float((mm >> 31) & (int)0xF149F2CAu); s[ti][r] = v; mx = fmaxf(mx, v); }
    } else {
#pragma unroll
        for (int ti = 0; ti < 5; ++ti)
#pragma unroll
            for (int r = 0; r < 16; ++r) { float v = s[ti][r];
                if (ti == 0 || ti == 4) { const int cc = 32 * ti + (r & 3) + 8 * (r >> 2); const int mm = min(dA + cc, dB - cc); v += __int_as_float((mm >> 31) & (int)0xF149F2CAu); s[ti][r] = v; }
                mx = fmaxf(mx, v); }
    }
    mx = fmaxf(mx, __shfl_xor(mx, 32));
    float l = 0.f;
#pragma unroll
    for (int ti = 0; ti < 5; ++ti)
#pragma unroll
        for (int r = 0; r < 16; ++r) { const float p = __builtin_amdgcn_exp2f(s[ti][r] - mx); s[ti][r] = p; l += p; }
    l += __shfl_xor(l, 32); l += __builtin_amdgcn_exp2f(sink2 - mx);
    inv_l = __builtin_amdgcn_rcpf(l);
}
template <int VS>
__device__ __forceinline__ void attn_pv(LAS const unsigned char* Vl, const f32x16 (&s)[5], int kt0, int lane, f32x16 (&o)[2]) {
    const int l31 = lane & 31, hi = lane >> 5;
    o[0] = (f32x16){}; o[1] = (f32x16){};
#pragma unroll
    for (int ti = 0; ti < 5; ++ti)
#pragma unroll
        for (int c2 = 0; c2 < 2; ++c2) {
            u32x4 pw; pw.x = pk2(s[ti][8 * c2 + 0], s[ti][8 * c2 + 1]); pw.y = pk2(s[ti][8 * c2 + 2], s[ti][8 * c2 + 3]); pw.z = pk2(s[ti][8 * c2 + 4], s[ti][8 * c2 + 5]); pw.w = pk2(s[ti][8 * c2 + 6], s[ti][8 * c2 + 7]);
            const bf16x8 pf = __builtin_bit_cast(bf16x8, pw);
            const int kb = 32 * (kt0 + ti) + 16 * c2 + 4 * hi;
#pragma unroll
            for (int dh = 0; dh < 2; ++dh) {
                const u64 lo = *(LAS const u64*)(Vl + (32 * dh + l31) * VS + kb * 2), hi8 = *(LAS const u64*)(Vl + (32 * dh + l31) * VS + (kb + 8) * 2);
                u32x4 vw; vw.x = (unsigned)lo; vw.y = (unsigned)(lo >> 32); vw.z = (unsigned)hi8; vw.w = (unsigned)(hi8 >> 32);
                o[dh] = __builtin_amdgcn_mfma_f32_32x32x16_bf16(__builtin_bit_cast(bf16x8, vw), pf, o[dh], 0, 0, 0);
            }
        }
}
template <int VS, bool SMP>
__device__ __forceinline__ void attn_job(LAS const unsigned char* Kl, LAS const unsigned char* Vl, LAS unsigned char* stg, const bf16_t* Q, const bf16_t* SGA, bf16_t* MIX, size_t row0, int head0, int kt0, int qi, int kjmin, float sink2, int lane) {
    const int l31 = lane & 31, hi = lane >> 5;
    const size_t qrow = SMP ? row0 + ((l31 >> 2) & 3) : row0 + l31; const int qhead = SMP ? head0 + (l31 & 3) : head0;
    bf16x8 qf[4];
#pragma unroll
    for (int c = 0; c < 4; ++c) { qf[c] = gld<bf16x8>(Q + qrow * 512 + qhead * 64 + 16 * c + 8 * hi); if (SMP && l31 >= 16) qf[c] = (bf16x8){0, 0, 0, 0, 0, 0, 0, 0}; }
    f32x16 s[5], o[2]; float inv_l;
    attn_qk<VS>(Kl, qf, kt0, qi, kjmin, sink2, lane, s, inv_l);
    const int ch = lane & 3; size_t grow[2]; int gcol[2]; u32x4 g[2][2];
#pragma unroll
    for (int i = 0; i < 2; ++i) { const int rr = (lane >> 2) + 16 * i;
        grow[i] = SMP ? row0 + (rr >> 2) : row0 + rr; gcol[i] = (SMP ? head0 + (rr & 3) : head0) * 64 + 8 * ch;
#pragma unroll
        for (int dh = 0; dh < 2; ++dh) g[i][dh] = (SMP && i == 1) ? (u32x4){0u, 0u, 0u, 0u} : gld<u32x4>(SGA + grow[i] * 512 + gcol[i] + 32 * dh); }
    attn_pv<VS>(Vl, s, kt0, lane, o);
    const int fq = (l31 >> 1) & 3;
#pragma unroll
    for (int dh = 0; dh < 2; ++dh) {
#pragma unroll
        for (int r4 = 0; r4 < 4; ++r4) { f32x4 v; v[0] = o[dh][4 * r4 + 0] * inv_l; v[1] = o[dh][4 * r4 + 1] * inv_l; v[2] = o[dh][4 * r4 + 2] * inv_l; v[3] = o[dh][4 * r4 + 3] * inv_l;
            *(LAS u32x2*)(stg + l31 * 64 + ((r4 ^ fq) * 16) + 8 * hi) = pk4(v); }
        asm volatile("s_waitcnt lgkmcnt(0)" ::: "memory");
#pragma unroll
        for (int i = 0; i < 2; ++i) { if (SMP && i == 1) continue;
            const int rr = (lane >> 2) + 16 * i; const u32x4 w = *(LAS const u32x4*)(stg + rr * 64 + ((ch ^ ((rr >> 1) & 3)) * 16)); const u32x4 gg = g[i][dh];
            u32x4 r; r.x = pk2(bflo(w.x) * bflo(gg.x), bfhi(w.x) * bfhi(gg.x)); r.y = pk2(bflo(w.y) * bflo(gg.y), bfhi(w.y) * bfhi(gg.y)); r.z = pk2(bflo(w.z) * bflo(gg.z), bfhi(w.z) * bfhi(gg.z)); r.w = pk2(bflo(w.w) * bflo(gg.w), bfhi(w.w) * bfhi(gg.w));
            gst<u32x4>(MIX + grow[i] * 1024 + gcol[i] + 32 * dh, r); }
        asm volatile("s_waitcnt lgkmcnt(0)" ::: "memory");
    }
}
__device__ __forceinline__ void unpack8(u32x4 w, float (&f)[8]) { f[0] = bflo(w.x); f[1] = bfhi(w.x); f[2] = bflo(w.y); f[3] = bfhi(w.y); f[4] = bflo(w.z); f[5] = bfhi(w.z); f[6] = bflo(w.w); f[7] = bfhi(w.w); }
template <int NT>
__device__ __forceinline__ void conv_rows(const bf16_t* U, const bf16_t* BGC, bf16_t* MIX, const float* cw, size_t row0, int c0, float (&p2v)[8], float (&p1v)[8]) {
    float w0[8], w1[8], w2[8];
#pragma unroll
    for (int e = 0; e < 8; ++e) { w0[e] = gld<float>(cw + e); w1[e] = gld<float>(cw + 512 + e); w2[e] = gld<float>(cw + 1024 + e); }
    u32x4 ur[NT], br[NT];
#pragma unroll
    for (int i = 0; i < NT; ++i) { ur[i] = gld<u32x4>(U + (row0 + i) * 512 + c0); br[i] = gld<u32x4>(BGC + (row0 + i) * 512 + c0); }
#pragma unroll
    for (int i = 0; i < NT; ++i) {
        float uc[8], bg[8], y[8]; unpack8(ur[i], uc); unpack8(br[i], bg);
#pragma unroll
        for (int e = 0; e < 8; ++e) { y[e] = bg[e] * (w0[e] * p2v[e] + w1[e] * p1v[e] + w2[e] * uc[e]); p2v[e] = p1v[e]; p1v[e] = uc[e]; }
        u32x4 w; w.x = pk2(y[0], y[1]); w.y = pk2(y[2], y[3]); w.z = pk2(y[4], y[5]); w.w = pk2(y[6], y[7]);
        gst<u32x4>(MIX + (row0 + i) * 1024 + 512 + c0, w);
    }
}

struct P2Args { const bf16_t *Q, *K, *V, *SGA, *BGC, *U; bf16_t* MIX; const float *cache_k, *cache_v, *state, *sinks, *conv_w; float* out; };
__device__ __forceinline__ P2Args p2_args() { unsigned char* ws = ka_ws(); return P2Args{(const bf16_t*)(ws + WS_Q), (const bf16_t*)(ws + WS_K), (const bf16_t*)(ws + WS_V), (const bf16_t*)(ws + WS_SGA), (const bf16_t*)(ws + WS_BGC), (const bf16_t*)(ws + WS_U), (bf16_t*)(ws + WS_MIX), ka_in(2), ka_in(3), ka_in(4), ka_in(9), ka_in(10), ka_out()}; }
__device__ __forceinline__ void p2_phase(LAS unsigned char* lds, const int L, const int w0) {
    int tid_ = TID_OF(w0); asm volatile("" : "+v"(tid_));
    const int wid = __builtin_amdgcn_readfirstlane(tid_ >> 6);
#define P2_RELAUNDER() int tid = tid_; asm volatile("" : "+v"(tid)); const int lane = tid & 63, l31 = lane & 31; (void)l31; (void)lane
    LAS unsigned short* vt = (LAS unsigned short*)(lds + VOFF); LAS unsigned short* svt = (LAS unsigned short*)(lds + SV_OFF);
    for (int item = blockIdx.x; item < 256; item += gridDim.x) {
        const P2Args A = p2_args();
        const int xj = item & 7, xx = item >> 3, b = xj, n = xx >> 1, kvh = xx & 1, sb = 16 * xj + (xx >> 1);
        const size_t cb = ((size_t)(L * 128 + sb) * 128) * 128 + kvh * 64;
        __syncthreads();
        {
            P2_RELAUNDER();
            u32x4 kv[4], vv[4]; f32x4 kq[4], vq[4];
#pragma unroll
            for (int it = 0; it < 4; ++it) {
                const int idx = it * 512 + tid, kj = idx >> 3, ch = idx & 7, kp = 128 * (n - 1) + kj;
                kv[it] = (u32x4){0u, 0u, 0u, 0u}; vv[it] = (u32x4){0u, 0u, 0u, 0u};
                if (kp >= 0) { const size_t r = (size_t)(b * 2048 + kp); kv[it] = gld<u32x4>(A.K + r * 128 + kvh * 64 + ch * 8); vv[it] = gld<u32x4>(A.V + r * 128 + kvh * 64 + ch * 8); }
                const int j = idx >> 4, c16 = idx & 15;
                kq[it] = gld_nt<f32x4>(A.cache_k + cb + (size_t)j * 128 + c16 * 4); vq[it] = gld_nt<f32x4>(A.cache_v + cb + (size_t)j * 128 + c16 * 4);
            }
#pragma unroll
            for (int it = 0; it < 4; ++it) {
                const int idx = it * 512 + tid, kj = idx >> 3, ch = idx & 7;
                *(LAS u32x4*)(lds + kj * KSTR + ch * 16) = kv[it];
#pragma unroll
                for (int e = 0; e < 8; ++e) { const unsigned w = vv[it][e >> 1]; vt[(ch * 8 + e) * (VSTR / 2) + kj] = (unsigned short)((e & 1) ? (w >> 16) : (w & 0xffffu)); }
                const int j = idx >> 4, c16 = idx & 15;
                *(LAS u32x2*)(lds + SK_OFF + j * KSTR + c16 * 8) = pk4(kq[it]);
                const u32x2 vw = pk4(vq[it]);
                svt[(c16 * 4 + 0) * (VSTR_S / 2) + j] = (unsigned short)(vw.x & 0xffffu); svt[(c16 * 4 + 1) * (VSTR_S / 2) + j] = (unsigned short)(vw.x >> 16);
                svt[(c16 * 4 + 2) * (VSTR_S / 2) + j] = (unsigned short)(vw.y & 0xffffu); svt[(c16 * 4 + 3) * (VSTR_S / 2) + j] = (unsigned short)(vw.y >> 16);
                if (j >= 4) { gst_nt<f32x4>(A.out + O_NKS + cb + (size_t)(j - 4) * 128 + c16 * 4, kq[it]); gst_nt<f32x4>(A.out + O_NVS + cb + (size_t)(j - 4) * 128 + c16 * 4, vq[it]); }
            }
            if (tid < 32) {
                const int t = tid >> 3, ch = tid & 7; const size_t r = (size_t)(NPR + 4 * sb + t);
                const u32x4 k4 = gld<u32x4>(A.K + r * 128 + kvh * 64 + ch * 8), v4 = gld<u32x4>(A.V + r * 128 + kvh * 64 + ch * 8);
                *(LAS u32x4*)(lds + SK_OFF + (128 + t) * KSTR + ch * 16) = k4;
#pragma unroll
                for (int e = 0; e < 8; ++e) { const unsigned w = v4[e >> 1]; svt[(ch * 8 + e) * (VSTR_S / 2) + 128 + t] = (unsigned short)((e & 1) ? (w >> 16) : (w & 0xffffu)); }
            }
            { unsigned z = 0u; asm volatile("" : "+v"(z));
              if (tid < 252) *(LAS u32x4*)(lds + SK_OFF + 132 * KSTR + tid * 16) = (u32x4){z, z, z, z};
              if (tid < 448) { const int d = tid / 7, q = tid % 7; *(LAS u32x2*)(lds + SV_OFF + d * VSTR_S + 264 + q * 8) = (u32x2){z, z}; } }
        }
        __syncthreads();
        {
            P2_RELAUNDER();
            const int head = 4 * kvh + (wid >> 1); const float sink2 = gld<float>(A.sinks + L * 8 + head) * LOG2E;
#pragma unroll 1
            for (int aa = 0; aa < 2; ++aa) {
                const int a = 2 * (wid & 1) + aa; const size_t row0 = (size_t)(b * 2048 + 128 * n + 32 * a);
                attn_job<VSTR, false>(lds, lds + VOFF, lds + STG_OFF + wid * 2048, A.Q, A.SGA, A.MIX, row0, head, a, 32 * a + l31, n == 0 ? 128 : 0, sink2, lane);
            }
        }
        if (wid == 0) {
            P2_RELAUNDER();
            const int t = (l31 >> 2) & 3, head = 4 * kvh + (l31 & 3); const float sink2 = gld<float>(A.sinks + L * 8 + head) * LOG2E;
            attn_job<VSTR_S, true>(lds + SK_OFF, lds + SV_OFF, lds + STG_OFF, A.Q, A.SGA, A.MIX, (size_t)(NPR + 4 * sb), 4 * kvh, 0, t, 0, sink2, lane);
        } else {
            P2_RELAUNDER();
            const int hw = (wid - 1) * 2 + (lane >> 5), c0 = 256 * kvh + 8 * l31; const float* cw = A.conv_w + (size_t)L * 3 * 512 + c0;
#pragma unroll 1
            for (int un = hw; un < 17; un += 14) {
                float p2v[8], p1v[8];
                if (un < 16) {
                    const int t0 = 128 * n + 8 * un; const size_t rb = (size_t)b * 2048;
#pragma unroll
                    for (int e = 0; e < 8; ++e) { p2v[e] = 0.f; p1v[e] = 0.f; }
                    if (t0 >= 2) { unpack8(gld<u32x4>(A.U + (rb + t0 - 2) * 512 + c0), p2v); unpack8(gld<u32x4>(A.U + (rb + t0 - 1) * 512 + c0), p1v); }
                    conv_rows<8>(A.U, A.BGC, A.MIX, cw, rb + t0, c0, p2v, p1v);
                } else {
                    const float* st = A.state + ((size_t)(L * 128 + sb) * 2) * 512 + c0;
#pragma unroll
                    for (int e = 0; e < 8; ++e) { p2v[e] = gld<float>(st + e); p1v[e] = gld<float>(st + 512 + e); }
                    conv_rows<4>(A.U, A.BGC, A.MIX, cw, (size_t)(NPR + 4 * sb), c0, p2v, p1v);
                }
            }
        }
    }
    __syncthreads();
#undef P2_RELAUNDER
}

__device__ __forceinline__ float wave_sum(float v) {
#pragma unroll
    for (int o = 1; o < 64; o <<= 1) v += __shfl_xor(v, o);
    return v;
}
__device__ __forceinline__ int win_src_col(int nb) {
    const int pn = nb >> 3, q = nb & 7, bj = q >> 2, wc = q & 3;
    if (pn < 2) return (4 * pn + wc) * 64 + 32 * bj;
    if (pn == 2) return wc < 2 ? 512 + wc * 64 + 32 * bj : 640 + 64 * bj + (wc - 2) * 32;
    if (pn < 5) return 768 + (pn - 3) * 256 + q * 32;
    if (pn < 9) return (bj == 0 ? 1280 : 2816) + 128 * (pn - 5) + wc * 32;
    return (bj == 0 ? 1792 : 2304) + 128 * (pn - 9) + wc * 32;
}
__device__ __forceinline__ void tr_item64(const float* W, int N, int K, int src_a, int src_b, const float* g, bf16_t* WT, int dst_row0, int k0, LAS float* scr, int lane) {
    const int sc = (lane < 32 ? src_a : src_b) + (lane & 31);
    float v[64];
#pragma unroll
    for (int kk = 0; kk < 64; ++kk) v[kk] = gld_nt<float>(W + (size_t)(k0 + kk) * N + sc);
#pragma unroll
    for (int kk = 0; kk < 64; ++kk) scr[kk * 65 + lane] = g ? v[kk] * gld<float>(g + k0 + kk) : v[kk];
    asm volatile("s_waitcnt lgkmcnt(0)" ::: "memory");
    const int c = lane & 7;
#pragma unroll
    for (int j = 0; j < 8; ++j) { const int n = (lane >> 3) + 8 * j; const LAS float* sp = scr + (8 * c) * 65 + n;
        u32x4 o; o.x = pk2(sp[0 * 65], sp[1 * 65]); o.y = pk2(sp[2 * 65], sp[3 * 65]); o.z = pk2(sp[4 * 65], sp[5 * 65]); o.w = pk2(sp[6 * 65], sp[7 * 65]);
        gst<u32x4>(WT + (size_t)(dst_row0 + n) * K + k0 + 8 * c, o); }
    asm volatile("s_waitcnt lgkmcnt(0)" ::: "memory");
}
struct Args { const float* in[15]; float* out; unsigned char* ws; int ph_lo, ph_hi; };
__device__ __forceinline__ void p0_phase(LAS unsigned char* lds, const Args& a, const int w0) {
    const int tid = TID_OF(w0), lane = tid & 63, wid = __builtin_amdgcn_readfirstlane(tid >> 6);
    const int gw = blockIdx.x * 8 + wid, NGW = gridDim.x * 8;
    LAS float* scr = (LAS float*)(lds + wid * 16640);
    unsigned char* ws = a.ws;
    constexpr int I_IN = DEPTH * 52 * 16, I_SQ = DEPTH * 16 * 16, I_PP = DEPTH * 16 * 4;
    const int gt = blockIdx.x * 512 + tid, GT = gridDim.x * 512;
    const bool weights_first = ((blockIdx.x >> 3) & 1) == 0;
#pragma unroll 1
    for (int step = 0; step < 2; ++step) {
      if ((step == 0) == weights_first) {
    for (int it = gw; it < I_IN + 2 * I_SQ + I_PP; it += NGW) {
        int r = it;
        if (r < I_IN) { const int L = r / (52 * 16), q = r % (52 * 16), nb = q % 52, kb = q / 52;
            tr_item64(a.in[8] + (size_t)L * DM * INW, INW, DM, win_src_col(2 * nb), win_src_col(2 * nb + 1), a.in[7] + L * DM, (bf16_t*)(ws + WS_WIN) + (size_t)L * INW * DM, nb * 64, kb * 64, scr, lane); continue; }
        r -= I_IN;
        if (r < 2 * I_SQ) { const int which = r / I_SQ; r %= I_SQ; const int L = r / 256, q = r % 256, nb = q & 15, kb = q >> 4;
            tr_item64(a.in[which ? 12 : 11] + (size_t)L * DM * DM, DM, DM, nb * 64, nb * 64 + 32, nullptr, (bf16_t*)(ws + (which ? WS_WPG : WS_WOUT)) + (size_t)L * DM * DM, nb * 64, kb * 64, scr, lane); continue; }
        r -= 2 * I_SQ;
        { const int L = r / 64, q = r % 64, nb = q & 15, kb = q >> 4;
            tr_item64(a.in[13] + (size_t)L * PLE * DM, DM, PLE, nb * 64, nb * 64 + 32, nullptr, (bf16_t*)(ws + WS_WPP) + (size_t)L * DM * PLE, nb * 64, kb * 64, scr, lane); }
    }
      } else {
    for (int row = gw; row < MR; row += 2 * NGW) {
        const int row1 = row + NGW; const bool has1 = row1 < MR; const int r1 = has1 ? row1 : row;
        const float* xr0 = row < NPR ? a.in[0] + (size_t)row * DM : a.in[1] + (size_t)(row - NPR) * DM;
        const float* xr1 = r1 < NPR ? a.in[0] + (size_t)r1 * DM : a.in[1] + (size_t)(r1 - NPR) * DM;
        f32x4 v0[4], v1[4];
#pragma unroll
        for (int j = 0; j < 4; ++j) { v0[j] = gld_nt<f32x4>(xr0 + 4 * lane + 256 * j); v1[j] = gld_nt<f32x4>(xr1 + 4 * lane + 256 * j); }
        float s0 = 0.f, s1 = 0.f;
        bf16_t* xb0 = (bf16_t*)(ws + WS_XB0) + (size_t)row * DM; bf16_t* xb1 = (bf16_t*)(ws + WS_XB0) + (size_t)r1 * DM;
#pragma unroll
        for (int j = 0; j < 4; ++j) { s0 += (v0[j][0] * v0[j][0] + v0[j][1] * v0[j][1]) + (v0[j][2] * v0[j][2] + v0[j][3] * v0[j][3]); s1 += (v1[j][0] * v1[j][0] + v1[j][1] * v1[j][1]) + (v1[j][2] * v1[j][2] + v1[j][3] * v1[j][3]);
            *(u32x2*)(xb0 + 4 * lane + 256 * j) = pk4(v0[j]); if (has1) *(u32x2*)(xb1 + 4 * lane + 256 * j) = pk4(v1[j]); }
        s0 = wave_sum(s0); s1 = wave_sum(s1);
        if (lane < 16) { ((float*)(ws + WS_SSP))[(size_t)row * 16 + lane] = lane == 0 ? s0 : 0.f; if (has1) ((float*)(ws + WS_SSP))[(size_t)row1 * 16 + lane] = lane == 0 ? s1 : 0.f; }
    }
    for (int i = gt; i < DEPTH * MR * 64; i += 4 * GT) {
        f32x4 v[4];
#pragma unroll
        for (int j = 0; j < 4; ++j) { const int ii = i + j * GT; const int ic = ii < DEPTH * MR * 64 ? ii : i; const int L = ic / (MR * 64), q = ic % (MR * 64), row = q >> 6, c4 = q & 63;
            const float* src = row < NPR ? a.in[5] + ((size_t)L * NPR + row) * PLE : a.in[6] + ((size_t)L * NSR + row - NPR) * PLE; v[j] = gld_nt<f32x4>(src + c4 * 4); }
#pragma unroll
        for (int j = 0; j < 4; ++j) { const int ii = i + j * GT; if (ii < DEPTH * MR * 64) *(u32x2*)((bf16_t*)(ws + WS_PB) + (size_t)ii * 4) = pk4(v[j]); }
    }
      }
    }
    for (int i = gt; i < 2052 * 32; i += GT) {
        const int pidx = i >> 5, d = i & 31; const double pos = pidx < 2048 ? (double)pidx : (double)(8192 + pidx - 2048);
        double inv = 1.0; for (int k = 0; k < d; ++k) inv *= 0.74989420933245582730;
        double rev = pos * inv * 0.15915494309189533577; rev -= __builtin_floor(rev);
        const float f = (float)rev; float* tp = (float*)(ws + WS_TAB) + (size_t)pidx * 64 + d;
        tp[0] = __builtin_amdgcn_cosf(f); tp[32] = __builtin_amdgcn_sinf(f);
    }
}
__device__ __forceinline__ void final_phase(const int w0) {
    int tid_ = TID_OF(w0); asm volatile("" : "+v"(tid_)); const int tid = tid_, lane = tid & 63, wid = tid >> 6; const int gw = blockIdx.x * 8 + wid, NGW = gridDim.x * 8;
    unsigned char* ws = ka_ws(); const float* ssp = (const float*)(ws + WS_SSP); const bf16_t* X0 = (const bf16_t*)(ws + WS_XB0); const float* gf = ka_in(14); float* outp = ka_out();
    f32x4 g[4];
#pragma unroll
    for (int j = 0; j < 4; ++j) g[j] = gld<f32x4>(gf + 4 * lane + 256 * j);
    for (int row = gw; row < MR; row += 2 * NGW) {
        const int row1 = row + NGW; const bool has1 = row1 < MR; const int r1 = has1 ? row1 : row;
        float s0 = lane < 16 ? gld<float>(ssp + (size_t)row * 16 + lane) : 0.f, s1 = lane < 16 ? gld<float>(ssp + (size_t)r1 * 16 + lane) : 0.f;
        u32x2 v0[4], v1[4];
#pragma unroll
        for (int j = 0; j < 4; ++j) { v0[j] = gld<u32x2>(X0 + (size_t)row * DM + 4 * lane + 256 * j); v1[j] = gld<u32x2>(X0 + (size_t)r1 * DM + 4 * lane + 256 * j); }
        s0 = wave_sum(s0); s1 = wave_sum(s1);
        const float rs0 = __builtin_amdgcn_rsqf(s0 * (1.f / 1024.f) + EPS), rs1 = __builtin_amdgcn_rsqf(s1 * (1.f / 1024.f) + EPS);
#pragma unroll
        for (int j = 0; j < 4; ++j) { gst_nt<f32x4>(outp + (size_t)row * DM + 4 * lane + 256 * j, bf4(v0[j]) * rs0 * g[j]); if (has1) gst_nt<f32x4>(outp + (size_t)row1 * DM + 4 * lane + 256 * j, bf4(v1[j]) * rs1 * g[j]); }
    }
}

#define RLX_AGENT __ATOMIC_RELAXED, __HIP_MEMORY_SCOPE_AGENT
#define XB_TMO      128
#define XB_XCNT(j)  (256  + 64 * (j))
#define XB_XSUB(j)  (1280 + 64 * (j))
#define XB_XGEN(j)  (2304 + 64 * (j))
#define XB_TOP      3328
#define XB_TOPGEN   3392
#define XCD_BAR_WORDS 3456
#define XB_SPIN_CAP (1u << 18)

__device__ __forceinline__ unsigned xb_ld(unsigned* p)              { return __hip_atomic_load((GAS unsigned*)p, __ATOMIC_RELAXED, __HIP_MEMORY_SCOPE_AGENT); }
__device__ __forceinline__ unsigned xb_add(unsigned* p, unsigned v) { return __hip_atomic_fetch_add((GAS unsigned*)p, v, __ATOMIC_RELAXED, __HIP_MEMORY_SCOPE_AGENT); }
__device__ __forceinline__ unsigned xb_xcc_id() { return (unsigned)__builtin_amdgcn_s_getreg((3 << 11) | 20) & 0xFu; }
#define XB_SPIN(cond, bar) do { unsigned _sp = 0; while (cond) { __builtin_amdgcn_s_sleep(1); \
    if ((++_sp & 255u) == 0u) { if (xb_ld(&(bar)[XB_TMO])) break; if (_sp > XB_SPIN_CAP) { atomicAdd(&(bar)[XB_TMO], 1u); break; } } } } while (0)

struct XcdBarrier {
    unsigned* bar; unsigned x; int w0;
    volatile LAS unsigned* st;
};

__device__ __forceinline__ XcdBarrier xcd_barrier_post(unsigned* bar, volatile LAS unsigned* st, int w0) {
    XcdBarrier b; b.bar = bar; b.x = xb_xcc_id(); b.st = st; b.w0 = w0;
    if (TID_OF(w0) == 0) (void)xb_add(&bar[XB_XCNT(b.x)], 1u);
    return b;
}
__device__ __forceinline__ void xcd_barrier_complete(unsigned* bar, unsigned x, unsigned& nloc, unsigned& nx) {
    const unsigned G = gridDim.x * gridDim.y * gridDim.z;
    unsigned sum, cnt, mine, sp = 0u;
    for (;;) {
        sum = 0u; cnt = 0u; mine = 0u;
#pragma unroll
        for (unsigned j = 0; j < 16; ++j) { const unsigned c = xb_ld(&bar[XB_XCNT(j)]); sum += c; cnt += (c > 0u) ? 1u : 0u; mine = (j == x) ? c : mine; }
        if (sum == G) break;
        __builtin_amdgcn_s_sleep(1);
        if ((++sp & 255u) == 0u) { if (xb_ld(&bar[XB_TMO])) break; if (sp > XB_SPIN_CAP) { atomicAdd(&bar[XB_TMO], 1u); break; } }
    }
    nloc = mine > 0u ? mine : 1u; nx = cnt > 0u ? cnt : 1u;
}

__device__ __forceinline__ void xcd_barrier(const XcdBarrier& b) {
    asm volatile("s_waitcnt vmcnt(0)" ::: "memory");
    __syncthreads();
    if (TID_OF(b.w0) == 0) {
        unsigned* bar = b.bar; unsigned bx = b.x; asm volatile("" : "+s"(bar), "+s"(bx));
        __builtin_amdgcn_s_waitcnt(0);
        unsigned nloc = b.st[0], nx = b.st[1];
        if (nloc == 0u) { xcd_barrier_complete(bar, bx, nloc, nx); b.st[0] = nloc; b.st[1] = nx; }
        const unsigned old = xb_add(&bar[XB_XSUB(bx)], 1u);
        const unsigned gen = old / nloc;
        if (old + 1u == (gen + 1u) * nloc) {
            __builtin_amdgcn_fence(__ATOMIC_RELEASE, "agent");
            asm volatile("s_waitcnt vmcnt(0)" ::: "memory");
            const unsigned og = xb_add(&bar[XB_TOP], 1u);
            const unsigned tg = og / nx;
            if (og + 1u == (tg + 1u) * nx) xb_add(&bar[XB_TOPGEN], 1u);
            else XB_SPIN(xb_ld(&bar[XB_TOPGEN]) == tg, bar);
            __builtin_amdgcn_fence(__ATOMIC_ACQUIRE, "agent");
            xb_add(&bar[XB_XGEN(bx)], 1u);
            asm volatile("s_waitcnt vmcnt(0)" ::: "memory");
        } else {
            XB_SPIN(xb_ld(&bar[XB_XGEN(bx)]) == gen, bar);
            __builtin_amdgcn_fence(__ATOMIC_ACQUIRE, "agent");
            asm volatile("s_waitcnt vmcnt(0)" ::: "memory");
        }
    }
    __syncthreads();
}

#ifndef MK_SPLIT
#define MK_SPLIT 0
#endif
__device__ __forceinline__ unsigned char* opq(unsigned char* p) { asm volatile("" : "+s"(p)); return p; }
__global__ void __launch_bounds__(512, 2) fwd(Args a) {
    extern __shared__ __attribute__((aligned(16))) unsigned char lds_raw[];
    LAS unsigned char* lds = (LAS unsigned char*)lds_raw;
    cg::grid_group grid = cg::this_grid();
    volatile LAS unsigned* misc = (volatile LAS unsigned*)(lds + 139264);
    if (a.ph_hi == 0x7fffffff) grid.sync();
    const int w0 = __builtin_amdgcn_readfirstlane((int)threadIdx.x >> 6);
    if (TID_OF(w0) < 16) misc[TID_OF(w0)] = 0u;
    __syncthreads();
    const XcdBarrier bar = xcd_barrier_post((unsigned*)(a.ws + WS_BAR), misc, w0);
    const int G = gridDim.x, c = blockIdx.x;
#if MK_SPLIT
    const int lo = a.ph_lo, hi = a.ph_hi;
#define IN(k) (lo <= (k) && (k) < hi)
#define SEAM(k) do { if (IN(k) && IN((k) + 1)) grid.sync(); } while (0)
#else
#define IN(k) true
#define SEAM(k) xcd_barrier(bar)
#endif
#ifndef DIS_P0
    if (IN(0)) p0_phase(lds, a, w0);
#endif
    SEAM(0);
#pragma unroll 1
    for (int L = 0; L < DEPTH; ++L) {
        const int ph = 1 + 4 * L;
        if (IN(ph)) {
            int cp_ = c; asm volatile("" : "+s"(cp_)); const bool pp_first = ((cp_ >> 3) & 1) != 0;
#pragma unroll 1
            for (int step = 0; step < 2; ++step) {
                if ((step == 0) != pp_first) {
                    unsigned char* ws = ka_ws();
                    pg8::Gemm g{(const bf16_t*)(ws + WS_XB0), (const bf16_t*)(ws + WS_WIN) + (size_t)L * INW * DM, MR, INW, DM}; int c1_ = c; asm volatile("" : "+s"(c1_)); pg8::StaticOrder S; S.init(MR, INW, G, c1_);
                    EpiIn E{L};
                    pg8::gemm_phase<EpiIn, pg8::StaticOrder, true, true>(lds, g, S, E, w0);
                } else {
                    unsigned char* ws = ka_ws();
                    pg8::Gemm g{(const bf16_t*)(ws + WS_PB) + (size_t)L * MR * PLE, (const bf16_t*)(ws + WS_WPP) + (size_t)L * DM * PLE, MR, DM, PLE};
                    const int nu = (MR / 256) * (INW / 256); int c2_ = c; asm volatile("" : "+s"(c2_)); FillOrder S; S.init(MR, DM, G, c2_, nu % G);
                    EpiPP E{0};
                    pg8::gemm_phase<EpiPP, FillOrder, true, true>(lds, g, S, E, w0);
                }
            }
        }
        SEAM(ph);
        if (IN(ph + 1)) {
#ifndef DIS_P2
            unsigned char* ws = ka_ws();
            p2_phase(lds, L, w0);
#endif
        }
        SEAM(ph + 1);
        if (IN(ph + 2)) {
#ifndef DIS_P3A
            unsigned char* ws = ka_ws();
            pg8::Gemm g{(const bf16_t*)(ws + WS_MIX), (const bf16_t*)(ws + WS_WOUT) + (size_t)L * DM * DM, NPR, DM, DM}; pg8::StaticOrder S; S.init(NPR, DM, G, c);
            EpiOut E{0};
            int cb_ = c; asm volatile("" : "+s"(cb_)); const bool small_first = ((cb_ >> 3) & 1) == 0;
#pragma unroll 1
            for (int step = 0; step < 2; ++step) {
                if ((step == 0) == small_first) small_gemm<EpiOut>(lds, g.A + (size_t)NPR * DM, g.Bt, E, w0);
                else pg8::gemm_phase<EpiOut, pg8::StaticOrder, true, true>(lds, g, S, E, w0);
            }
#endif
        }
        SEAM(ph + 2);
        if (IN(ph + 3)) {
#ifndef DIS_P3B
            unsigned char* ws = ka_ws();
            pg8::Gemm g{(const bf16_t*)(ws + WS_XB1), (const bf16_t*)(ws + WS_WPG) + (size_t)L * DM * DM, NPR, DM, DM}; pg8::StaticOrder S; S.init(NPR, DM, G, c);
            EpiGate E{0};
            int cb_ = c; asm volatile("" : "+s"(cb_)); const bool small_first = ((cb_ >> 3) & 1) == 0;
#pragma unroll 1
            for (int step = 0; step < 2; ++step) {
                if ((step == 0) == small_first) small_gemm<EpiGate>(lds, g.A + (size_t)NPR * DM, g.Bt, E, w0);
                else pg8::gemm_phase<EpiGate, pg8::StaticOrder, true, true>(lds, g, S, E, w0);
            }
#endif
        }
        SEAM(ph + 3);
    }
    if (IN(17)) final_phase(w0);
#undef IN
#undef SEAM
}

extern "C" void kernel_launch(void* const* d_in, const int* in_sizes, int n_in, void* d_out, int out_size, void* d_ws, size_t ws_size, hipStream_t stream) {
    static int grid = 0;
    if (grid == 0) {
        if (n_in != 15 || (size_t)out_size != O_END || ws_size < WS_END) { fprintf(stderr, "kernel_launch: unexpected shapes (n_in %d out %d ws %zu)\n", n_in, out_size, ws_size); grid = -1; return; }
        int dev = 0, cus = 0, per = 0;
        if (hipGetDevice(&dev) != hipSuccess || hipDeviceGetAttribute(&cus, hipDeviceAttributeMultiprocessorCount, dev) != hipSuccess) { grid = -1; return; }
        if (hipFuncSetAttribute((const void*)fwd, hipFuncAttributeMaxDynamicSharedMemorySize, LDS_BYTES) != hipSuccess) { fprintf(stderr, "kernel_launch: hipFuncSetAttribute failed\n"); grid = -1; return; }
        if (hipOccupancyMaxActiveBlocksPerMultiprocessor(&per, (const void*)fwd, 512, LDS_BYTES) != hipSuccess || per < 1) { fprintf(stderr, "kernel_launch: occupancy query %d\n", per); per = 1; }
        (void)hipGetLastError();
        grid = cus;
        fprintf(stderr, "kernel_launch: grid %d (cus %d x per_cu %d), ws %zu\n", grid, cus, per, ws_size);
    }
    if (grid < 0) return;
    if (hipMemsetAsync((char*)d_ws + WS_BAR, 0, 16384, stream) != hipSuccess) { fprintf(stderr, "kernel_launch: memset failed\n"); return; }
    Args a{};
    for (int i = 0; i < 15; ++i) a.in[i] = (const float*)d_in[i];
    a.out = (float*)d_out; a.ws = (unsigned char*)d_ws;
#if MK_SPLIT
    for (int ph = 0; ph < 18; ++ph) { a.ph_lo = ph; a.ph_hi = ph + 1; hipLaunchKernelGGL(fwd, dim3(grid), dim3(512), LDS_BYTES, stream, a); }
#else
    a.ph_lo = 0; a.ph_hi = 18;
    void* args[] = {&a};
    const hipError_t e = hipLaunchCooperativeKernel((const void*)fwd, dim3(grid), dim3(512), args, LDS_BYTES, stream);
    if (e != hipSuccess) fprintf(stderr, "kernel_launch: cooperative launch failed: %s (grid %d)\n", hipGetErrorString(e), grid);
#endif
}
```

```cpp
#include <hip/hip_runtime.h>
#include <hip/hip_cooperative_groups.h>
#include <cstdio>
#include <cstdint>
namespace cg = cooperative_groups;
__device__ __forceinline__ int lane_id() { int l; asm volatile("v_mbcnt_lo_u32_b32 %0, -1, 0\n\tv_mbcnt_hi_u32_b32 %0, -1, %0" : "=v"(l)); return l; }
#define TID_OF(w0) ((w0) * 64 + lane_id())
namespace pg8 {
#define PG8_LAS __attribute__((address_space(3)))
typedef unsigned short bf16_t;
typedef short bf16x8 __attribute__((ext_vector_type(8)));
typedef float f32x4 __attribute__((ext_vector_type(4)));
typedef unsigned u32x4 __attribute__((ext_vector_type(4)));
constexpr int BM = 256, BK = 64, HALF = 128, HTB = HALF * BK * 2  , STAGE_BYTES = 8 * HTB, NXCD = 8, WGM = 8;

__host__ __device__ __forceinline__ int lds_byte(int r, int c) { const int st = (r >> 4) * 2 + (c >> 5), rr = r & 15, cc = c & 31, ob = rr * 64 + cc * 2; return st * 1024 + (ob ^ (((ob >> 9) & 1) << 5)); }
__host__ __device__ __forceinline__ void stage_rc(int b, int& R, int& C) { const int st = b / 1024, sb = b % 1024, swz = sb ^ (((sb >> 9) & 1) << 5); R = (st >> 1) * 16 + swz / 64; C = (st & 1) * 32 + (swz % 64) / 2; }
__host__ __device__ __forceinline__ int perm32(int rho) { const int n = rho >> 4, i = rho & 15; return 8 * (i >> 2) + 4 * n + (i & 3); }

struct Unit { int pm, pn; };
struct Gemm { const bf16_t* A; const bf16_t* Bt; int M, N, K; };

struct StaticOrder {
    int nM, nN, nwg, G, c;
    __host__ __device__ void init(int M, int N, int G_, int c_) { nM = M / BM; nN = N / BM; nwg = nM * nN; G = G_; c = c_; }
    __host__ __device__ bool next(int i, Unit& u) const {
        const long L = (long)i * G + c; if (L >= nwg) return false;
        int wgid = (int)L; { const int q = nwg / NXCD, r = nwg % NXCD, xcd = wgid % NXCD, off = wgid / NXCD; wgid = (xcd < r ? xcd * (q + 1) : r * (q + 1) + (xcd - r) * q) + off; }
        const int nig = WGM * nN, gid = wgid / nig, fm = gid * WGM, gsz = (nM - fm) < WGM ? (nM - fm) : WGM;
        u.pm = fm + ((wgid % nig) % gsz); u.pn = (wgid % nig) / gsz; return true;
    }
    __device__ __forceinline__ void a_ready(const Unit&) const {}
    __device__ __forceinline__ void done(const Unit&) const {}
};

__device__ __forceinline__ unsigned cvt_pk_bf16(float lo, float hi) { unsigned r; asm volatile("v_cvt_pk_bf16_f32 %0, %1, %2" : "=v"(r) : "v"(lo), "v"(hi)); return r; }
typedef float f32x2 __attribute__((ext_vector_type(2)));
template <class Epi, class Sched, bool ALIGN_EPI = false, bool SP2 = false>
__device__ __forceinline__ void gemm_phase(PG8_LAS unsigned char* lds, const Gemm g, const Sched& S, const Epi& E, const int w0) {
    int tid_ = TID_OF(w0); asm volatile("" : "+v"(tid_));
    const int tid = tid_, wid = __builtin_amdgcn_readfirstlane(tid >> 6), lane = tid & 63, wr = wid >> 2, wc = wid & 3, fr = lane & 15, fq = lane >> 4;
    const int K = g.K, nt = K / BK;
    unsigned voffA[2], voffB[2];
#pragma unroll
    for (int i = 0; i < 2; ++i) { int R, C; stage_rc(tid * 16 + i * 8192, R, C); const int Rb = Epi::PERM ? ((R & ~31) + perm32(R & 31)) : R;
        voffA[i] = (unsigned)(R * K + C) * 2u; voffB[i] = (unsigned)(Rb * K + C) * 2u; }
    const size_t kstep = (size_t)(BK * 2);
    const size_t hstep = (size_t)HALF * K * 2;
    const size_t tstep = 2 * hstep;
    const unsigned ldsw = (unsigned)wid * 1024u;
    const int aoff = lds_byte(wr * 64 + fr, fq * 8), boff = lds_byte(wc * 32 + fr, fq * 8);
#define PG8_SA(b, h) (((b) * 2 + (h)) * HTB)
#define PG8_SB(b, h) ((4 + (b) * 2 + (h)) * HTB)
#define PG8_STAGE(bufoff, gbase, voff) do { _Pragma("unroll") for (int _i = 0; _i < 2; ++_i) \
        __builtin_amdgcn_global_load_lds((const unsigned*)((const char*)(gbase) + (voff)[_i]), (PG8_LAS unsigned*)(lds + (bufoff) + ldsw + _i * 8192), 16, 0, 0); } while (0)
#define PG8_LDA(dst, b, h) do { _Pragma("unroll") for (int m = 0; m < 4; ++m) _Pragma("unroll") for (int k = 0; k < 2; ++k) dst[m][k] = *(const PG8_LAS bf16x8*)(lds + PG8_SA(b, h) + aoff + m * 2048 + k * 1024); } while (0)
#define PG8_LDB(dst, b, h) do { _Pragma("unroll") for (int n = 0; n < 2; ++n) _Pragma("unroll") for (int k = 0; k < 2; ++k) dst[n][k] = *(const PG8_LAS bf16x8*)(lds + PG8_SB(b, h) + boff + n * 2048 + k * 1024); } while (0)
#define PG8_MMA(ai, bj, At, Bt) do { __builtin_amdgcn_s_setprio(1); _Pragma("unroll") for (int m = 0; m < 4; ++m) _Pragma("unroll") for (int n = 0; n < 2; ++n) _Pragma("unroll") for (int k = 0; k < 2; ++k) \
        acc[ai][bj][m][n] = __builtin_amdgcn_mfma_f32_16x16x32_bf16(Bt[n][k], At[m][k], acc[ai][bj][m][n], 0, 0, 0); __builtin_amdgcn_s_setprio(0); } while (0)
#define PG8_WAIT_V(n) asm volatile("s_waitcnt vmcnt(" #n ")" ::: "memory")
#define PG8_WAIT_L(n) asm volatile("s_waitcnt lgkmcnt(" #n ")" ::: "memory")
#define PG8_BAR __builtin_amdgcn_s_barrier()
#define PG8_SCHED __builtin_amdgcn_sched_barrier(0)
    Unit cur, nxt; int ui = 0;
    if (!S.next(0, cur)) return;
    f32x4 acc[2][2][4][2];
#pragma unroll
    for (int a = 0; a < 2; ++a)
#pragma unroll
        for (int b = 0; b < 2; ++b)
#pragma unroll
            for (int m = 0; m < 4; ++m)
#pragma unroll
                for (int n = 0; n < 2; ++n) acc[a][b][m][n] = (f32x4){0.f, 0.f, 0.f, 0.f};
    bf16x8 At[4][2], B0[2][2], B1[2][2];
    const char* cA = (const char*)g.A + (size_t)cur.pm * tstep; const char* cB = (const char*)g.Bt + (size_t)cur.pn * tstep;
    S.a_ready(cur);
    if constexpr (SP2) {
        PG8_STAGE(PG8_SB(0, 0), cB, voffB); PG8_STAGE(PG8_SB(0, 1), cB + hstep, voffB); PG8_STAGE(PG8_SA(0, 0), cA, voffA); PG8_STAGE(PG8_SA(0, 1), cA + hstep, voffA);
        if (wr == 1) PG8_BAR;
        PG8_WAIT_V(2); PG8_BAR;
        PG8_STAGE(PG8_SB(1, 0), cB + kstep, voffB); PG8_STAGE(PG8_SA(1, 0), cA + kstep, voffA); PG8_STAGE(PG8_SB(1, 1), cB + hstep + kstep, voffB);
        PG8_WAIT_V(6); PG8_BAR;
    } else {
        PG8_STAGE(PG8_SB(0, 0), cB, voffB); PG8_STAGE(PG8_SA(0, 0), cA, voffA); PG8_STAGE(PG8_SB(0, 1), cB + hstep, voffB); PG8_STAGE(PG8_SA(0, 1), cA + hstep, voffA);
        if (wr == 1) PG8_BAR;
        PG8_WAIT_V(4); PG8_BAR;
        PG8_STAGE(PG8_SB(1, 0), cB + kstep, voffB); PG8_STAGE(PG8_SA(1, 0), cA + kstep, voffA); PG8_STAGE(PG8_SB(1, 1), cB + hstep + kstep, voffB);
        PG8_WAIT_V(6); PG8_BAR;
    }
    for (;;) {
        const bool has_next = S.next(ui + 1, nxt);
        const char* nA = has_next ? (const char*)g.A + (size_t)nxt.pm * tstep : cA; const char* nB = has_next ? (const char*)g.Bt + (size_t)nxt.pn * tstep : cB;
#pragma unroll 1
        for (int t = 0; t < nt; t += 2) {
            const bool last = (t == nt - 2);
            const char* a1 = cA + (size_t)(t + 1) * kstep;
            const char* a2 = last ? nA : cA + (size_t)(t + 2) * kstep; const char* b2 = last ? nB : cB + (size_t)(t + 2) * kstep;
            const char* a3 = a2 + kstep; const char* b3 = b2 + kstep;
            if (last && has_next) S.a_ready(nxt);
            if constexpr (SP2) {
            PG8_LDB(B0, 0, 0); PG8_LDB(B1, 0, 1); PG8_SCHED; PG8_LDA(At, 0, 0); PG8_STAGE(PG8_SA(1, 1), a1 + hstep, voffA);
            PG8_WAIT_V(8); PG8_WAIT_L(0); PG8_BAR; PG8_MMA(0, 0, At, B0); PG8_MMA(0, 1, At, B1); PG8_BAR; PG8_SCHED;
            PG8_LDA(At, 0, 1); PG8_STAGE(PG8_SB(0, 0), b2, voffB); PG8_STAGE(PG8_SB(0, 1), b2 + hstep, voffB); PG8_STAGE(PG8_SA(0, 0), a2, voffA);
            PG8_WAIT_V(8); PG8_WAIT_L(0); PG8_BAR; PG8_MMA(1, 0, At, B0); PG8_MMA(1, 1, At, B1); PG8_BAR; PG8_SCHED;
            PG8_LDB(B0, 1, 0); PG8_LDB(B1, 1, 1); PG8_SCHED; PG8_LDA(At, 1, 0); PG8_STAGE(PG8_SA(0, 1), a2 + hstep, voffA);
            PG8_WAIT_V(8); PG8_WAIT_L(0); PG8_BAR; PG8_MMA(0, 0, At, B0); PG8_MMA(0, 1, At, B1); PG8_BAR; PG8_SCHED;
            PG8_LDA(At, 1, 1); PG8_STAGE(PG8_SB(1, 0), b3, voffB); PG8_STAGE(PG8_SB(1, 1), b3 + hstep, voffB); PG8_STAGE(PG8_SA(1, 0), a3, voffA);
            PG8_WAIT_V(8); PG8_WAIT_L(0); PG8_BAR; PG8_MMA(1, 0, At, B0); PG8_MMA(1, 1, At, B1); PG8_BAR; PG8_SCHED;
            } else {
            PG8_LDB(B0, 0, 0); PG8_SCHED; PG8_LDA(At, 0, 0); PG8_STAGE(PG8_SA(1, 1), a1 + hstep, voffA);
            PG8_WAIT_L(8); PG8_BAR; PG8_WAIT_L(0); PG8_MMA(0, 0, At, B0); PG8_BAR; PG8_SCHED;
            PG8_LDB(B1, 0, 1); PG8_STAGE(PG8_SB(0, 0), b2, voffB);
            PG8_BAR; PG8_WAIT_L(0); PG8_MMA(0, 1, At, B1); PG8_BAR;
            PG8_LDA(At, 0, 1); PG8_STAGE(PG8_SA(0, 0), a2, voffA);
            PG8_BAR; PG8_WAIT_L(0); PG8_MMA(1, 0, At, B0); PG8_BAR; PG8_SCHED;
            PG8_STAGE(PG8_SB(0, 1), b2 + hstep, voffB);
            PG8_WAIT_V(6); PG8_BAR; PG8_MMA(1, 1, At, B1); PG8_BAR;
            PG8_LDB(B0, 1, 0); PG8_SCHED; PG8_LDA(At, 1, 0); PG8_STAGE(PG8_SA(0, 1), a2 + hstep, voffA);
            PG8_WAIT_L(8); PG8_BAR; PG8_WAIT_L(0); PG8_MMA(0, 0, At, B0); PG8_BAR; PG8_SCHED;
            PG8_LDB(B1, 1, 1); PG8_STAGE(PG8_SB(1, 0), b3, voffB);
            PG8_BAR; PG8_WAIT_L(0); PG8_MMA(0, 1, At, B1); PG8_BAR;
            PG8_LDA(At, 1, 1); PG8_STAGE(PG8_SA(1, 0), a3, voffA);
            PG8_BAR; PG8_WAIT_L(0); PG8_MMA(1, 0, At, B0); PG8_BAR; PG8_SCHED;
            PG8_STAGE(PG8_SB(1, 1), b3 + hstep, voffB);
            PG8_WAIT_V(6); PG8_BAR; PG8_MMA(1, 1, At, B1); PG8_BAR;
            }
        }
        if constexpr (ALIGN_EPI) { if (wr == 0) PG8_BAR; }
        if constexpr (!Epi::AFTER_DRAIN) { E(acc, cur, wr, wc, fr, fq); S.done(cur); }
        if (!has_next) break;
#pragma unroll
        for (int a = 0; a < 2; ++a)
#pragma unroll
            for (int b = 0; b < 2; ++b)
#pragma unroll
                for (int m = 0; m < 4; ++m)
#pragma unroll
                    for (int n = 0; n < 2; ++n) acc[a][b][m][n] = (f32x4){0.f, 0.f, 0.f, 0.f};
        cur = nxt; cA = nA; cB = nB; ++ui;
        if constexpr (ALIGN_EPI) { if (wr == 1) PG8_BAR; }
    }
    PG8_WAIT_V(0);
    if constexpr (!ALIGN_EPI) { if (wr == 0) PG8_BAR; }
    PG8_BAR;
    if constexpr (Epi::AFTER_DRAIN) { E.fused(acc, cur, wr, wc, fr, fq, lds, wid, lane); S.done(cur); }
#undef PG8_SA
#undef PG8_SB
#undef PG8_STAGE
#undef PG8_LDA
#undef PG8_LDB
#undef PG8_MMA
#undef PG8_WAIT_V
#undef PG8_WAIT_L
#undef PG8_BAR
#undef PG8_SCHED
}
}

#define GAS __attribute__((address_space(1)))
#define LAS __attribute__((address_space(3)))
using pg8::bf16_t; using pg8::bf16x8; using pg8::f32x4; using pg8::u32x4;
typedef unsigned u32x2 __attribute__((ext_vector_type(2)));
typedef float f32x16 __attribute__((ext_vector_type(16)));
constexpr int DM = 1024, NPR = 16384, NSR = 512, MR = NPR + NSR, DEPTH = 4, INW = 3328, PLE = 256;
constexpr float EPS = 1e-6f, LOG2E = 1.4426950408889634f, QS = 0.125f * 1.4426950408889634f;
constexpr size_t O_NKP = 17301504, O_NVP = 17825792, O_NCP = 18350080, O_NKS = 18382848, O_NVS = 26771456, O_NCS = 35160064, O_END = 35684352;
constexpr size_t MiB = 1u << 20;
constexpr size_t WS_SSP = 0  , WS_TAB = 253 * MiB  , WS_WIN = 2 * MiB, WS_WOUT = 28 * MiB, WS_WPG = 36 * MiB, WS_WPP = 44 * MiB, WS_XB0 = 46 * MiB, WS_PB = 79 * MiB, WS_PP = 112 * MiB,
                 WS_MIX = 145 * MiB, WS_Q = 178 * MiB, WS_SGA = WS_Q + 16 * MiB + MiB / 2, WS_XB1 = WS_Q, WS_BGC = 211 * MiB, WS_U = WS_BGC + 16 * MiB + MiB / 2, WS_K = 244 * MiB,
                 WS_V = WS_K + 4 * MiB + MiB / 8, WS_BAR = 254 * MiB  , WS_END = 255 * MiB;
static_assert(WS_V + 4 * MiB + MiB / 8 <= WS_TAB && WS_TAB + 2052 * 64 * 4 <= WS_BAR && (size_t)MR * 16 * 4 <= 2 * MiB && WS_END <= 256 * MiB, "ws map");
constexpr int LDS_BYTES = 147456;
template <class T, class P> __device__ __forceinline__ T gld(P p) { return *(GAS const T*)p; }
template <class T, class P> __device__ __forceinline__ void gst(P p, T v) { *(GAS T*)p = v; }
template <class T, class P> __device__ __forceinline__ void gst_nt(P p, T v) { __builtin_nontemporal_store(v, (GAS T*)p); }
template <class T, class P> __device__ __forceinline__ T gld_nt(P p) { return __builtin_nontemporal_load((GAS const T*)p); }

__device__ __forceinline__ unsigned pk2(float lo, float hi) { return pg8::cvt_pk_bf16(lo, hi); }
__device__ __forceinline__ u32x4 pk8(f32x4 a, f32x4 b) { u32x4 w; w.x = pk2(a[0], a[1]); w.y = pk2(a[2], a[3]); w.z = pk2(b[0], b[1]); w.w = pk2(b[2], b[3]); return w; }
__device__ __forceinline__ u32x2 pk4(f32x4 a) { u32x2 w; w.x = pk2(a[0], a[1]); w.y = pk2(a[2], a[3]); return w; }
__device__ __forceinline__ float bflo(unsigned w) { return __uint_as_float(w << 16); }
__device__ __forceinline__ float bfhi(unsigned w) { return __uint_as_float(w & 0xffff0000u); }
__device__ __forceinline__ float sigm(float x) { return __builtin_amdgcn_rcpf(1.f + __builtin_amdgcn_exp2f(-x * LOG2E)); }
__device__ __forceinline__ f32x4 silu4(f32x4 x) { f32x4 r; for (int i = 0; i < 4; ++i) r[i] = x[i] * sigm(x[i]); return r; }
__device__ __forceinline__ f32x4 sigm4(f32x4 x) { f32x4 r; for (int i = 0; i < 4; ++i) r[i] = sigm(x[i]); return r; }
__device__ __forceinline__ float row_rs(const float* ssp, int row, int fq) {
    const f32x4 v = gld<f32x4>(ssp + (size_t)row * 16 + fq * 4); float s = (v[0] + v[1]) + (v[2] + v[3]);
    s += __shfl_xor(s, 16); s += __shfl_xor(s, 32);
    return __builtin_amdgcn_rsqf(s * (1.f / 1024.f) + EPS);
}


typedef __attribute__((address_space(4))) const unsigned char* kptr_t;
__device__ __forceinline__ unsigned long long ka_u64(int off) { kptr_t p = (kptr_t)__builtin_amdgcn_kernarg_segment_ptr(); asm volatile("" : "+s"(p)); return *(__attribute__((address_space(4))) const unsigned long long*)(p + off); }
__device__ __forceinline__ const float* ka_in(int k) { return (const float*)(GAS const float*)ka_u64(8 * k); }
__device__ __forceinline__ float* ka_out() { return (float*)(GAS float*)ka_u64(120); }
__device__ __forceinline__ unsigned char* ka_ws() { return (unsigned char*)(GAS unsigned char*)ka_u64(128); }

struct EpiIn {
    static constexpr bool PERM = true, AFTER_DRAIN = false;
    int L;
    struct Ld { f32x4 ss, c0, c1, s0, s1; };
    __device__ __forceinline__ void operator()(const f32x4 (&acc)[2][2][4][2], const pg8::Unit& u, int wr, int wc, int fr_, int fq_) const {
        int lane_ = fr_ + 16 * fq_; asm volatile("" : "+v"(lane_)); const int fr = lane_ & 15, fq = lane_ >> 4;
        const int pn = u.pn; unsigned char* ws = ka_ws(); float* out = ka_out();
        const float* ssp = (const float*)(ws + WS_SSP); const float* tab = (const float*)(ws + WS_TAB);
        bf16_t *Q = (bf16_t*)(ws + WS_Q), *K = (bf16_t*)(ws + WS_K), *V = (bf16_t*)(ws + WS_V), *SGA = (bf16_t*)(ws + WS_SGA), *BGC = (bf16_t*)(ws + WS_BGC), *U = (bf16_t*)(ws + WS_U);
        const bool rope = pn < 2 || (pn == 2 && wc < 2);
        const int row0 = u.pm * 256 + wr * 64 + fr, cw = wc * 32 + fq * 8;
        Ld ld[8];
#pragma unroll
        for (int it = 0; it < 10; ++it) {
            if (it < 8) {
                const int row = row0 + (it >> 2) * 128 + (it & 3) * 16;
                ld[it].ss = gld<f32x4>(ssp + (size_t)row * 16 + fq * 4);
                if (rope) { const int pidx = row < NPR ? (row & 2047) : 2048 + (row & 3); const float* tp = tab + (size_t)pidx * 64 + fq * 8;
                    ld[it].c0 = gld<f32x4>(tp); ld[it].c1 = gld<f32x4>(tp + 4); ld[it].s0 = gld<f32x4>(tp + 32); ld[it].s1 = gld<f32x4>(tp + 36); }
            }
            if (it >= 2) {
                const int k = it - 2, ai = k >> 2, m = k & 3, row = row0 + ai * 128 + m * 16;
                float sq = (ld[k].ss[0] + ld[k].ss[1]) + (ld[k].ss[2] + ld[k].ss[3]); sq += __shfl_xor(sq, 16); sq += __shfl_xor(sq, 32);
                const float rs = __builtin_amdgcn_rsqf(sq * (1.f / 1024.f) + EPS);
                const f32x4 a0 = acc[ai][0][m][0] * rs, a1 = acc[ai][0][m][1] * rs, b0 = acc[ai][1][m][0] * rs, b1 = acc[ai][1][m][1] * rs;
                if (rope) {
                    const f32x4 c0 = ld[k].c0, c1 = ld[k].c1, s0 = ld[k].s0, s1 = ld[k].s1;
                    f32x4 o1a = a0 * c0 - b0 * s0, o1b = a1 * c1 - b1 * s1, o2a = b0 * c0 + a0 * s0, o2b = b1 * c1 + a1 * s1;
                    if (pn < 2) {
                        o1a *= QS; o1b *= QS; o2a *= QS; o2b *= QS;
                        bf16_t* q = Q + (size_t)row * 512 + (4 * pn + wc) * 64 + fq * 8;
                        gst<u32x4>(q, pk8(o1a, o1b)); gst<u32x4>(q + 32, pk8(o2a, o2b));
                    } else {
                        bf16_t* kk = K + (size_t)row * 128 + wc * 64 + fq * 8;
                        gst<u32x4>(kk, pk8(o1a, o1b)); gst<u32x4>(kk + 32, pk8(o2a, o2b));
                        const bool smp = row >= NPR; const bool wr_out = smp || (row & 2047) >= 1920;
                        const size_t kofs = smp ? O_NKS + ((size_t)(L * 128 + ((row - NPR) >> 2)) * 128 + 124 + (row & 3)) * 128 : O_NKP + ((size_t)(L * 8 + (row >> 11)) * 128 + ((row & 2047) - 1920)) * 128;
                        if (wr_out) { float* ko = out + kofs + wc * 64 + fq * 8; gst<f32x4>(ko, o1a); gst<f32x4>(ko + 4, o1b); gst<f32x4>(ko + 32, o2a); gst<f32x4>(ko + 36, o2b); }
                    }
                } else if (pn == 2) {
                    bf16_t* v = V + (size_t)row * 128 + (wc - 2) * 32 + fq * 8;
                    gst<u32x4>(v, pk8(a0, a1)); gst<u32x4>(v + 64, pk8(b0, b1));
                    const bool smp = row >= NPR; const bool wr_out = smp || (row & 2047) >= 1920;
                    const size_t vofs = smp ? O_NVS + ((size_t)(L * 128 + ((row - NPR) >> 2)) * 128 + 124 + (row & 3)) * 128 : O_NVP + ((size_t)(L * 8 + (row >> 11)) * 128 + ((row & 2047) - 1920)) * 128;
                    if (wr_out) { float* vo = out + vofs + (wc - 2) * 32 + fq * 8; gst<f32x4>(vo, a0); gst<f32x4>(vo + 4, a1); gst<f32x4>(vo + 64, b0); gst<f32x4>(vo + 68, b1); }
                } else if (pn < 5) {
                    bf16_t* p = SGA + (size_t)row * 512 + (pn - 3) * 256 + cw;
                    gst<u32x4>(p, pk8(silu4(a0), silu4(a1))); gst<u32x4>(p + 128, pk8(silu4(b0), silu4(b1)));
                } else if (pn < 9) {
                    bf16_t* p = BGC + (size_t)row * 512 + (pn - 5) * 128 + cw;
                    gst<u32x4>(p, pk8(a0 * silu4(b0), a1 * silu4(b1)));
                } else {
                    const f32x4 u0 = a0 * b0, u1 = a1 * b1; const int c = (pn - 9) * 128 + cw;
                    gst<u32x4>(U + (size_t)row * 512 + c, pk8(u0, u1));
                    const bool smp = row >= NPR; const bool wr_out = smp ? (row & 3) >= 2 : (row & 2047) >= 2046;
                    const size_t uofs = smp ? O_NCS + ((size_t)(L * 128 + ((row - NPR) >> 2)) * 2 + ((row & 3) - 2)) * 512 : O_NCP + ((size_t)(L * 8 + (row >> 11)) * 2 + ((row & 2047) - 2046)) * 512;
                    if (wr_out) { float* uo = out + uofs + c; gst<f32x4>(uo, u0); gst<f32x4>(uo + 4, u1); }
                }
            }
        }
    }
};
struct EpiPP {
    static constexpr bool PERM = true, AFTER_DRAIN = false;
    int dummy;
    __device__ __forceinline__ void operator()(const f32x4 (&acc)[2][2][4][2], const pg8::Unit& u, int wr, int wc, int fr_, int fq_) const {
        int lane_ = fr_ + 16 * fq_; asm volatile("" : "+v"(lane_)); const int fr = lane_ & 15, fq = lane_ >> 4;
        bf16_t* O = (bf16_t*)(ka_ws() + WS_PP);
#pragma unroll
        for (int ai = 0; ai < 2; ++ai)
#pragma unroll
            for (int m = 0; m < 4; ++m) {
                bf16_t* p = O + (size_t)(u.pm * 256 + ai * 128 + wr * 64 + m * 16 + fr) * DM + u.pn * 256 + wc * 32 + fq * 8;
                *(u32x4*)p = pk8(acc[ai][0][m][0], acc[ai][0][m][1]); gst<u32x4>(p + 128, pk8(acc[ai][1][m][0], acc[ai][1][m][1]));
            }
    }
};
__device__ __forceinline__ f32x4 bf4(u32x2 w) { return (f32x4){bflo(w.x), bfhi(w.x), bflo(w.y), bfhi(w.y)}; }
struct EpiOut {
    static constexpr bool PERM = true, AFTER_DRAIN = false;
    int dummy;
    __device__ __forceinline__ void operator()(const f32x4 (&acc)[2][2][4][2], const pg8::Unit& u, int wr, int wc, int fr_, int fq_) const {
        int lane_ = fr_ + 16 * fq_; asm volatile("" : "+v"(lane_)); const int fr = lane_ & 15, fq = lane_ >> 4;
        unsigned char* ws = ka_ws(); const bf16_t* X0 = (const bf16_t*)(ws + WS_XB0); bf16_t* X1 = (bf16_t*)(ws + WS_XB1);
        const int row0 = u.pm * 256 + wr * 64 + fr, col0 = u.pn * 256 + wc * 32 + fq * 8;
        u32x4 xr[8][2];
#pragma unroll
        for (int it = 0; it < 10; ++it) {
            if (it < 8) { const size_t off = (size_t)(row0 + (it >> 2) * 128 + (it & 3) * 16) * DM + col0;
#pragma unroll
                for (int bj = 0; bj < 2; ++bj) xr[it][bj] = gld<u32x4>(X0 + off + bj * 128); }
            if (it >= 2) { const int k = it - 2, ai = k >> 2, m = k & 3; const size_t off = (size_t)(row0 + ai * 128 + m * 16) * DM + col0;
#pragma unroll
                for (int bj = 0; bj < 2; ++bj) { const u32x4 w = xr[k][bj];
                    gst<u32x4>(X1 + off + bj * 128, pk8(bf4((u32x2){w.x, w.y}) + acc[ai][bj][m][0], bf4((u32x2){w.z, w.w}) + acc[ai][bj][m][1])); } }
        }
    }
    __device__ __forceinline__ void small(f32x4 acc, int row, int col, int chunk) const {
        unsigned char* ws = ka_ws(); const bf16_t* X0 = (const bf16_t*)(ws + WS_XB0); bf16_t* X1 = (bf16_t*)(ws + WS_XB1);
        gst<u32x2>(X1 + (size_t)row * DM + col, pk4(bf4(gld<u32x2>(X0 + (size_t)row * DM + col)) + acc));
    }
};
struct EpiGate {
    static constexpr bool PERM = true, AFTER_DRAIN = false;
    int dummy;
    __device__ __forceinline__ void operator()(const f32x4 (&acc)[2][2][4][2], const pg8::Unit& u, int wr, int wc, int fr_, int fq_) const {
        int lane_ = fr_ + 16 * fq_; asm volatile("" : "+v"(lane_)); const int fr = lane_ & 15, fq = lane_ >> 4;
        unsigned char* ws = ka_ws(); const bf16_t* X1 = (const bf16_t*)(ws + WS_XB1); bf16_t* X0 = (bf16_t*)(ws + WS_XB0); const bf16_t* PP = (const bf16_t*)(ws + WS_PP); float* ssp = (float*)(ws + WS_SSP);
        const int row0 = u.pm * 256 + wr * 64 + fr, col0 = u.pn * 256 + wc * 32 + fq * 8;
        u32x4 xr[8][2], pr[8][2];
#pragma unroll
        for (int it = 0; it < 10; ++it) {
            if (it < 8) { const size_t off = (size_t)(row0 + (it >> 2) * 128 + (it & 3) * 16) * DM + col0;
#pragma unroll
                for (int bj = 0; bj < 2; ++bj) { xr[it][bj] = gld<u32x4>(X1 + off + bj * 128); pr[it][bj] = gld<u32x4>(PP + off + bj * 128); } }
            if (it >= 2) { const int k = it - 2, ai = k >> 2, m = k & 3, row = row0 + ai * 128 + m * 16; const size_t off = (size_t)row * DM + col0; float sq = 0.f;
#pragma unroll
                for (int bj = 0; bj < 2; ++bj) { const u32x4 xw = xr[k][bj], pw = pr[k][bj];
                    const u32x4 w = pk8(bf4((u32x2){xw.x, xw.y}) + sigm4(acc[ai][bj][m][0]) * bf4((u32x2){pw.x, pw.y}), bf4((u32x2){xw.z, xw.w}) + sigm4(acc[ai][bj][m][1]) * bf4((u32x2){pw.z, pw.w}));
                    gst<u32x4>(X0 + off + bj * 128, w);
                    const f32x4 y0 = bf4((u32x2){w.x, w.y}), y1 = bf4((u32x2){w.z, w.w});
                    sq += ((y0[0] * y0[0] + y0[1] * y0[1]) + (y0[2] * y0[2] + y0[3] * y0[3])) + ((y1[0] * y1[0] + y1[1] * y1[1]) + (y1[2] * y1[2] + y1[3] * y1[3])); }
                sq += __shfl_xor(sq, 16); sq += __shfl_xor(sq, 32);
                if (fq == 0) gst<float>(ssp + (size_t)row * 16 + u.pn * 4 + wc, sq); }
        }
    }
    __device__ __forceinline__ void small(f32x4 acc, int row, int col, int chunk) const {
        unsigned char* ws = ka_ws(); const bf16_t* X1 = (const bf16_t*)(ws + WS_XB1); bf16_t* X0 = (bf16_t*)(ws + WS_XB0); const bf16_t* PP = (const bf16_t*)(ws + WS_PP); float* ssp = (float*)(ws + WS_SSP);
        const u32x2 w = pk4(bf4(gld<u32x2>(X1 + (size_t)row * DM + col)) + sigm4(acc) * bf4(gld<u32x2>(PP + (size_t)row * DM + col))); const f32x4 x2 = bf4(w);
        gst<u32x2>(X0 + (size_t)row * DM + col, w);
        float sq = (x2[0] * x2[0] + x2[1] * x2[1]) + (x2[2] * x2[2] + x2[3] * x2[3]);
        sq += __shfl_xor(sq, 1); sq += __shfl_xor(sq, 2); sq += __shfl_xor(sq, 4); sq += __shfl_xor(sq, 8);
        if ((lane_id() & 15) == 0) gst<float>(ssp + (size_t)row * 16 + chunk, sq);
    }
};
struct FillOrder {
    int nN, nwg, c, rem, stride;
    __device__ void init(int M, int N, int G, int c_, int rem_) { nN = N / 256; nwg = (M / 256) * nN; c = c_; rem = rem_; stride = G - rem_; }
    __device__ bool next(int i, pg8::Unit& u) const { if (c < rem) return false; const int idx = (c - rem) + i * stride; if (idx >= nwg) return false; u.pm = idx / nN; u.pn = idx % nN; return true; }
    __device__ __forceinline__ void a_ready(const pg8::Unit&) const {}
    __device__ __forceinline__ void done(const pg8::Unit&) const {}
};

template <class Epi>
__device__ __forceinline__ void small_gemm(LAS unsigned char* lds, const bf16_t* A, const bf16_t* Bt, const Epi& E, const int w0) {
    int tid_ = TID_OF(w0); asm volatile("" : "+v"(tid_));
    const int tid = tid_, lane = tid & 63, wid = __builtin_amdgcn_readfirstlane(tid >> 6), fr = lane & 15, fq = lane >> 4;
    for (int tile = blockIdx.x; tile < 256; tile += gridDim.x) {
        const int rt = 2 * (tile & 7) + ((tile >> 3) & 1), ct = tile >> 4, k0 = wid * 128;
        bf16x8 af[2][4], bw[4][4];
#pragma unroll
        for (int i = 0; i < 2; ++i)
#pragma unroll
            for (int ks = 0; ks < 4; ++ks) af[i][ks] = gld<bf16x8>(A + (size_t)(rt * 32 + i * 16 + fr) * DM + k0 + ks * 32 + fq * 8);
#pragma unroll
        for (int j = 0; j < 4; ++j)
#pragma unroll
            for (int ks = 0; ks < 4; ++ks) bw[j][ks] = gld<bf16x8>(Bt + (size_t)(ct * 64 + j * 16 + fr) * DM + k0 + ks * 32 + fq * 8);
        f32x4 acc[2][4];
#pragma unroll
        for (int i = 0; i < 2; ++i)
#pragma unroll
            for (int j = 0; j < 4; ++j) { acc[i][j] = (f32x4){0.f, 0.f, 0.f, 0.f};
#pragma unroll
                for (int ks = 0; ks < 4; ++ks) acc[i][j] = __builtin_amdgcn_mfma_f32_16x16x32_bf16(bw[j][ks], af[i][ks], acc[i][j], 0, 0, 0); }
        __syncthreads();
#pragma unroll
        for (int i = 0; i < 2; ++i)
#pragma unroll
            for (int j = 0; j < 4; ++j) *(LAS f32x4*)(lds + ((wid * 8 + i * 4 + j) * 64 + lane) * 16) = acc[i][j];
        __syncthreads();
        const int row = tid >> 4, c4 = tid & 15, til = (row >> 4) * 4 + (c4 >> 2), l = (row & 15) + 16 * (c4 & 3);
        f32x4 sum = (f32x4){0.f, 0.f, 0.f, 0.f};
#pragma unroll
        for (int w = 0; w < 8; ++w) sum += *(LAS const f32x4*)(lds + ((w * 8 + til) * 64 + l) * 16);
        E.small(sum, NPR + rt * 32 + row, ct * 64 + c4 * 4, ct);
    }
    __syncthreads();
}

constexpr int KSTR = 144, VSTR = 520, VSTR_S = 328;
constexpr int VOFF = 256 * KSTR, SK_OFF = VOFF + 64 * VSTR, SV_OFF = SK_OFF + 160 * KSTR, P2_LDS_END = SV_OFF + 64 * VSTR_S;
constexpr int STG_OFF = P2_LDS_END;
static_assert(STG_OFF + 8 * 2048 <= 131072, "P2 LDS map");
typedef unsigned long long u64;
template <int VS>
__device__ __forceinline__ void attn_qk(LAS const unsigned char* Kl, const bf16x8 (&qf)[4], int kt0, int qi, int kjmin, float sink2, int lane, f32x16 (&s)[5], float& inv_l) {
    asm volatile("" : "+v"(qi), "+v"(lane));
    const int l31 = lane & 31, hi = lane >> 5;
#pragma unroll
    for (int ti = 0; ti < 5; ++ti) {
        f32x16 a = {};
#pragma unroll
        for (int c = 0; c < 4; ++c) { const bf16x8 kf = *(LAS const bf16x8*)(Kl + (32 * (kt0 + ti) + l31) * KSTR + (16 * c + 8 * hi) * 2); a = __builtin_amdgcn_mfma_f32_32x32x16_bf16(kf, qf[c], a, 0, 0, 0); }
        s[ti] = a;
    }
    float mx = sink2;
    const int kj0 = 32 * kt0 + 4 * hi, lo_ = max(qi + 1, kjmin), dA = kj0 - lo_, dB = qi + 128 - kj0;
    if (kjmin > 0) {
#pragma unroll
        for (int ti = 0; ti < 5; ++ti)
#pragma unroll
            for (int r = 0; r < 16; ++r) { const int cc = 32 * ti + (r & 3) + 8 * (r >> 2); const int mm = min(dA + cc, dB - cc);
                const float v = s[ti][r] + __int_as_float((mm >> 31) & (int)0xF149F2CAu); s[ti][r] = v; mx = fmaxf(mx, v); }
    } else {
#pragma unroll
        for (int ti = 0; ti < 5; ++ti)
#pragma unroll
            for (int r = 0; r < 16; ++r) { float v = s[ti][r];
                if (ti == 0 || ti == 4) { const int cc = 32 * ti + (r & 3) + 8 * (r >> 2); const int mm = min(dA + cc, dB - cc); v += __int_as_float((mm >> 31) & (int)0xF149F2CAu); s[ti][r] = v; }
                mx = fmaxf(mx, v); }
    }
    mx = fmaxf(mx, __shfl_xor(mx, 32));
    float l = 0.f;
#pragma unroll
    for (int ti = 0; ti < 5; ++ti)
#pragma unroll
        for (int r = 0; r < 16; ++r) { const float p = __builtin_amdgcn_exp2f(s[ti][r] - mx); s[ti][r] = p; l += p; }
    l += __shfl_xor(l, 32); l += __builtin_amdgcn_exp2f(sink2 - mx);
    inv_l = __builtin_amdgcn_rcpf(l);
}
template <int VS>
__device__ __forceinline__ void attn_pv(LAS const unsigned char* Vl, const f32x16 (&s)[5], int kt0, int lane, f32x16 (&o)[2]) {
    const int l31 = lane & 31, hi = lane >> 5;
    o[0] = (f32x16){}; o[1] = (f32x16){};
#pragma unroll
    for (int ti = 0; ti < 5; ++ti)
#pragma unroll
        for (int c2 = 0; c2 < 2; ++c2) {
            u32x4 pw; pw.x = pk2(s[ti][8 * c2 + 0], s[ti][8 * c2 + 1]); pw.y = pk2(s[ti][8 * c2 + 2], s[ti][8 * c2 + 3]); pw.z = pk2(s[ti][8 * c2 + 4], s[ti][8 * c2 + 5]); pw.w = pk2(s[ti][8 * c2 + 6], s[ti][8 * c2 + 7]);
            const bf16x8 pf = __builtin_bit_cast(bf16x8, pw);
            const int kb = 32 * (kt0 + ti) + 16 * c2 + 4 * hi;
#pragma unroll
            for (int dh = 0; dh < 2; ++dh) {
                const u64 lo = *(LAS const u64*)(Vl + (32 * dh + l31) * VS + kb * 2), hi8 = *(LAS const u64*)(Vl + (32 * dh + l31) * VS + (kb + 8) * 2);
                u32x4 vw; vw.x = (unsigned)lo; vw.y = (unsigned)(lo >> 32); vw.z = (unsigned)hi8; vw.w = (unsigned)(hi8 >> 32);
                o[dh] = __builtin_amdgcn_mfma_f32_32x32x16_bf16(__builtin_bit_cast(bf16x8, vw), pf, o[dh], 0, 0, 0);
            }
        }
}
template <int VS, bool SMP>
__device__ __forceinline__ void attn_job(LAS const unsigned char* Kl, LAS const unsigned char* Vl, LAS unsigned char* stg, const bf16_t* Q, const bf16_t* SGA, bf16_t* MIX, size_t row0, int head0, int kt0, int qi, int kjmin, float sink2, int lane) {
    const int l31 = lane & 31, hi = lane >> 5;
    const size_t qrow = SMP ? row0 + ((l31 >> 2) & 3) : row0 + l31; const int qhead = SMP ? head0 + (l31 & 3) : head0;
    bf16x8 qf[4];
#pragma unroll
    for (int c = 0; c < 4; ++c) { qf[c] = gld<bf16x8>(Q + qrow * 512 + qhead * 64 + 16 * c + 8 * hi); if (SMP && l31 >= 16) qf[c] = (bf16x8){0, 0, 0, 0, 0, 0, 0, 0}; }
    f32x16 s[5], o[2]; float inv_l;
    attn_qk<VS>(Kl, qf, kt0, qi, kjmin, sink2, lane, s, inv_l);
    const int ch = lane & 3; size_t grow[2]; int gcol[2]; u32x4 g[2][2];
#pragma unroll
    for (int i = 0; i < 2; ++i) { const int rr = (lane >> 2) + 16 * i;
        grow[i] = SMP ? row0 + (rr >> 2) : row0 + rr; gcol[i] = (SMP ? head0 + (rr & 3) : head0) * 64 + 8 * ch;
#pragma unroll
        for (int dh = 0; dh < 2; ++dh) g[i][dh] = (SMP && i == 1) ? (u32x4){0u, 0u, 0u, 0u} : gld<u32x4>(SGA + grow[i] * 512 + gcol[i] + 32 * dh); }
    attn_pv<VS>(Vl, s, kt0, lane, o);
    const int fq = (l31 >> 1) & 3;
#pragma unroll
    for (int dh = 0; dh < 2; ++dh) {
#pragma unroll
        for (int r4 = 0; r4 < 4; ++r4) { f32x4 v; v[0] = o[dh][4 * r4 + 0] * inv_l; v[1] = o[dh][4 * r4 + 1] * inv_l; v[2] = o[dh][4 * r4 + 2] * inv_l; v[3] = o[dh][4 * r4 + 3] * inv_l;
            *(LAS u32x2*)(stg + l31 * 64 + ((r4 ^ fq) * 16) + 8 * hi) = pk4(v); }
        asm volatile("s_waitcnt lgkmcnt(0)" ::: "memory");
#pragma unroll
        for (int i = 0; i < 2; ++i) { if (SMP && i == 1) continue;
            const int rr = (lane >> 2) + 16 * i; const u32x4 w = *(LAS const u32x4*)(stg + rr * 64 + ((ch ^ ((rr >> 1) & 3)) * 16)); const u32x4 gg = g[i][dh];
            u32x4 r; r.x = pk2(bflo(w.x) * bflo(gg.x), bfhi(w.x) * bfhi(gg.x)); r.y = pk2(bflo(w.y) * bflo(gg.y), bfhi(w.y) * bfhi(gg.y)); r.z = pk2(bflo(w.z) * bflo(gg.z), bfhi(w.z) * bfhi(gg.z)); r.w = pk2(bflo(w.w) * bflo(gg.w), bfhi(w.w) * bfhi(gg.w));
            gst<u32x4>(MIX + grow[i] * 1024 + gcol[i] + 32 * dh, r); }
        asm volatile("s_waitcnt lgkmcnt(0)" ::: "memory");
    }
}
__device__ __forceinline__ void unpack8(u32x4 w, float (&f)[8]) { f[0] = bflo(w.x); f[1] = bfhi(w.x); f[2] = bflo(w.y); f[3] = bfhi(w.y); f[4] = bflo(w.z); f[5] = bfhi(w.z); f[6] = bflo(w.w); f[7] = bfhi(w.w); }
template <int NT>
__device__ __forceinline__ void conv_rows(const bf16_t* U, const bf16_t* BGC, bf16_t* MIX, const float* cw, size_t row0, int c0, float (&p2v)[8], float (&p1v)[8]) {
    float w0[8], w1[8], w2[8];
#pragma unroll
    for (int e = 0; e < 8; ++e) { w0[e] = gld<float>(cw + e); w1[e] = gld<float>(cw + 512 + e); w2[e] = gld<float>(cw + 1024 + e); }
    u32x4 ur[NT], br[NT];
#pragma unroll
    for (int i = 0; i < NT; ++i) { ur[i] = gld<u32x4>(U + (row0 + i) * 512 + c0); br[i] = gld<u32x4>(BGC + (row0 + i) * 512 + c0); }
#pragma unroll
    for (int i = 0; i < NT; ++i) {
        float uc[8], bg[8], y[8]; unpack8(ur[i], uc); unpack8(br[i], bg);
#pragma unroll
        for (int e = 0; e < 8; ++e) { y[e] = bg[e] * (w0[e] * p2v[e] + w1[e] * p1v[e] + w2[e] * uc[e]); p2v[e] = p1v[e]; p1v[e] = uc[e]; }
        u32x4 w; w.x = pk2(y[0], y[1]); w.y = pk2(y[2], y[3]); w.z = pk2(y[4], y[5]); w.w = pk2(y[6], y[7]);
        gst<u32x4>(MIX + (row0 + i) * 1024 + 512 + c0, w);
    }
}

struct P2Args { const bf16_t *Q, *K, *V, *SGA, *BGC, *U; bf16_t* MIX; const float *cache_k, *cache_v, *state, *sinks, *conv_w; float* out; };
__device__ __forceinline__ P2Args p2_args() { unsigned char* ws = ka_ws(); return P2Args{(const bf16_t*)(ws + WS_Q), (const bf16_t*)(ws + WS_K), (const bf16_t*)(ws + WS_V), (const bf16_t*)(ws + WS_SGA), (const bf16_t*)(ws + WS_BGC), (const bf16_t*)(ws + WS_U), (bf16_t*)(ws + WS_MIX), ka_in(2), ka_in(3), ka_in(4), ka_in(9), ka_in(10), ka_out()}; }
__device__ __forceinline__ void p2_phase(LAS unsigned char* lds, const int L, const int w0) {
    int tid_ = TID_OF(w0); asm volatile("" : "+v"(tid_));
    const int wid = __builtin_amdgcn_readfirstlane(tid_ >> 6);
#define P2_RELAUNDER() int tid = tid_; asm volatile("" : "+v"(tid)); const int lane = tid & 63, l31 = lane & 31; (void)l31; (void)lane
    LAS unsigned short* vt = (LAS unsigned short*)(lds + VOFF); LAS unsigned short* svt = (LAS unsigned short*)(lds + SV_OFF);
    for (int item = blockIdx.x; item < 256; item += gridDim.x) {
        const P2Args A = p2_args();
        const int xj = item & 7, xx = item >> 3, b = xj, n = xx >> 1, kvh = xx & 1, sb = 16 * xj + (xx >> 1);
        const size_t cb = ((size_t)(L * 128 + sb) * 128) * 128 + kvh * 64;
        __syncthreads();
        {
            P2_RELAUNDER();
            u32x4 kv[4], vv[4]; f32x4 kq[4], vq[4];
#pragma unroll
            for (int it = 0; it < 4; ++it) {
                const int idx = it * 512 + tid, kj = idx >> 3, ch = idx & 7, kp = 128 * (n - 1) + kj;
                kv[it] = (u32x4){0u, 0u, 0u, 0u}; vv[it] = (u32x4){0u, 0u, 0u, 0u};
                if (kp >= 0) { const size_t r = (size_t)(b * 2048 + kp); kv[it] = gld<u32x4>(A.K + r * 128 + kvh * 64 + ch * 8); vv[it] = gld<u32x4>(A.V + r * 128 + kvh * 64 + ch * 8); }
                const int j = idx >> 4, c16 = idx & 15;
                kq[it] = gld_nt<f32x4>(A.cache_k + cb + (size_t)j * 128 + c16 * 4); vq[it] = gld_nt<f32x4>(A.cache_v + cb + (size_t)j * 128 + c16 * 4);
            }
#pragma unroll
            for (int it = 0; it < 4; ++it) {
                const int idx = it * 512 + tid, kj = idx >> 3, ch = idx & 7;
                *(LAS u32x4*)(lds + kj * KSTR + ch * 16) = kv[it];
#pragma unroll
                for (int e = 0; e < 8; ++e) { const unsigned w = vv[it][e >> 1]; vt[(ch * 8 + e) * (VSTR / 2) + kj] = (unsigned short)((e & 1) ? (w >> 16) : (w & 0xffffu)); }
                const int j = idx >> 4, c16 = idx & 15;
                *(LAS u32x2*)(lds + SK_OFF + j * KSTR + c16 * 8) = pk4(kq[it]);
                const u32x2 vw = pk4(vq[it]);
                svt[(c16 * 4 + 0) * (VSTR_S / 2) + j] = (unsigned short)(vw.x & 0xffffu); svt[(c16 * 4 + 1) * (VSTR_S / 2) + j] = (unsigned short)(vw.x >> 16);
                svt[(c16 * 4 + 2) * (VSTR_S / 2) + j] = (unsigned short)(vw.y & 0xffffu); svt[(c16 * 4 + 3) * (VSTR_S / 2) + j] = (unsigned short)(vw.y >> 16);
                if (j >= 4) { gst_nt<f32x4>(A.out + O_NKS + cb + (size_t)(j - 4) * 128 + c16 * 4, kq[it]); gst_nt<f32x4>(A.out + O_NVS + cb + (size_t)(j - 4) * 128 + c16 * 4, vq[it]); }
            }
            if (tid < 32) {
                const int t = tid >> 3, ch = tid & 7; const size_t r = (size_t)(NPR + 4 * sb + t);
                const u32x4 k4 = gld<u32x4>(A.K + r * 128 + kvh * 64 + ch * 8), v4 = gld<u32x4>(A.V + r * 128 + kvh * 64 + ch * 8);
                *(LAS u32x4*)(lds + SK_OFF + (128 + t) * KSTR + ch * 16) = k4;
#pragma unroll
                for (int e = 0; e < 8; ++e) { const unsigned w = v4[e >> 1]; svt[(ch * 8 + e) * (VSTR_S / 2) + 128 + t] = (unsigned short)((e & 1) ? (w >> 16) : (w & 0xffffu)); }
            }
            { unsigned z = 0u; asm volatile("" : "+v"(z));
              if (tid < 252) *(LAS u32x4*)(lds + SK_OFF + 132 * KSTR + tid * 16) = (u32x4){z, z, z, z};
              if (tid < 448) { const int d = tid / 7, q = tid % 7; *(LAS u32x2*)(lds + SV_OFF + d * VSTR_S + 264 + q * 8) = (u32x2){z, z}; } }
        }
        __syncthreads();
        {
            P2_RELAUNDER();
            const int head = 4 * kvh + (wid >> 1); const float sink2 = gld<float>(A.sinks + L * 8 + head) * LOG2E;
#pragma unroll 1
            for (int aa = 0; aa < 2; ++aa) {
                const int a = 2 * (wid & 1) + aa; const size_t row0 = (size_t)(b * 2048 + 128 * n + 32 * a);
                attn_job<VSTR, false>(lds, lds + VOFF, lds + STG_OFF + wid * 2048, A.Q, A.SGA, A.MIX, row0, head, a, 32 * a + l31, n == 0 ? 128 : 0, sink2, lane);
            }
        }
        if (wid == 0) {
            P2_RELAUNDER();
            const int t = (l31 >> 2) & 3, head = 4 * kvh + (l31 & 3); const float sink2 = gld<float>(A.sinks + L * 8 + head) * LOG2E;
            attn_job<VSTR_S, true>(lds + SK_OFF, lds + SV_OFF, lds + STG_OFF, A.Q, A.SGA, A.MIX, (size_t)(NPR + 4 * sb), 4 * kvh, 0, t, 0, sink2, lane);
        } else {
            P2_RELAUNDER();
            const int hw = (wid - 1) * 2 + (lane >> 5), c0 = 256 * kvh + 8 * l31; const float* cw = A.conv_w + (size_t)L * 3 * 512 + c0;
#pragma unroll 1
            for (int un = hw; un < 17; un += 14) {
                float p2v[8], p1v[8];
                if (un < 16) {
                    const int t0 = 128 * n + 8 * un; const size_t rb = (size_t)b * 2048;
#pragma unroll
                    for (int e = 0; e < 8; ++e) { p2v[e] = 0.f; p1v[e] = 0.f; }
                    if (t0 >= 2) { unpack8(gld<u32x4>(A.U + (rb + t0 - 2) * 512 + c0), p2v); unpack8(gld<u32x4>(A.U + (rb + t0 - 1) * 512 + c0), p1v); }
                    conv_rows<8>(A.U, A.BGC, A.MIX, cw, rb + t0, c0, p2v, p1v);
                } else {
                    const float* st = A.state + ((size_t)(L * 128 + sb) * 2) * 512 + c0;
#pragma unroll
                    for (int e = 0; e < 8; ++e) { p2v[e] = gld<float>(st + e); p1v[e] = gld<float>(st + 512 + e); }
                    conv_rows<4>(A.U, A.BGC, A.MIX, cw, (size_t)(NPR + 4 * sb), c0, p2v, p1v);
                }
            }
        }
    }
    __syncthreads();
#undef P2_RELAUNDER
}

__device__ __forceinline__ float wave_sum(float v) {
#pragma unroll
    for (int o = 1; o < 64; o <<= 1) v += __shfl_xor(v, o);
    return v;
}
__device__ __forceinline__ int win_src_col(int nb) {
    const int pn = nb >> 3, q = nb & 7, bj = q >> 2, wc = q & 3;
    if (pn < 2) return (4 * pn + wc) * 64 + 32 * bj;
    if (pn == 2) return wc < 2 ? 512 + wc * 64 + 32 * bj : 640 + 64 * bj + (wc - 2) * 32;
    if (pn < 5) return 768 + (pn - 3) * 256 + q * 32;
    if (pn < 9) return (bj == 0 ? 1280 : 2816) + 128 * (pn - 5) + wc * 32;
    return (bj == 0 ? 1792 : 2304) + 128 * (pn - 9) + wc * 32;
}
__device__ __forceinline__ void tr_item64(const float* W, int N, int K, int src_a, int src_b, const float* g, bf16_t* WT, int dst_row0, int k0, LAS float* scr, int lane) {
    const int sc = (lane < 32 ? src_a : src_b) + (lane & 31);
    float v[64];
#pragma unroll
    for (int kk = 0; kk < 64; ++kk) v[kk] = gld_nt<float>(W + (size_t)(k0 + kk) * N + sc);
#pragma unroll
    for (int kk = 0; kk < 64; ++kk) scr[kk * 65 + lane] = g ? v[kk] * gld<float>(g + k0 + kk) : v[kk];
    asm volatile("s_waitcnt lgkmcnt(0)" ::: "memory");
    const int c = lane & 7;
#pragma unroll
    for (int j = 0; j < 8; ++j) { const int n = (lane >> 3) + 8 * j; const LAS float* sp = scr + (8 * c) * 65 + n;
        u32x4 o; o.x = pk2(sp[0 * 65], sp[1 * 65]); o.y = pk2(sp[2 * 65], sp[3 * 65]); o.z = pk2(sp[4 * 65], sp[5 * 65]); o.w = pk2(sp[6 * 65], sp[7 * 65]);
        gst<u32x4>(WT + (size_t)(dst_row0 + n) * K + k0 + 8 * c, o); }
    asm volatile("s_waitcnt lgkmcnt(0)" ::: "memory");
}
struct Args { const float* in[15]; float* out; unsigned char* ws; int ph_lo, ph_hi; };
__device__ __forceinline__ void p0_phase(LAS unsigned char* lds, const Args& a, const int w0) {
    const int tid = TID_OF(w0), lane = tid & 63, wid = __builtin_amdgcn_readfirstlane(tid >> 6);
    const int gw = blockIdx.x * 8 + wid, NGW = gridDim.x * 8;
    LAS float* scr = (LAS float*)(lds + wid * 16640);
    unsigned char* ws = a.ws;
    constexpr int I_IN = DEPTH * 52 * 16, I_SQ = DEPTH * 16 * 16, I_PP = DEPTH * 16 * 4;
    const int gt = blockIdx.x * 512 + tid, GT = gridDim.x * 512;
    const bool weights_first = ((blockIdx.x >> 3) & 1) == 0;
#pragma unroll 1
    for (int step = 0; step < 2; ++step) {
      if ((step == 0) == weights_first) {
    for (int it = gw; it < I_IN + 2 * I_SQ + I_PP; it += NGW) {
        int r = it;
        if (r < I_IN) { const int L = r / (52 * 16), q = r % (52 * 16), nb = q % 52, kb = q / 52;
            tr_item64(a.in[8] + (size_t)L * DM * INW, INW, DM, win_src_col(2 * nb), win_src_col(2 * nb + 1), a.in[7] + L * DM, (bf16_t*)(ws + WS_WIN) + (size_t)L * INW * DM, nb * 64, kb * 64, scr, lane); continue; }
        r -= I_IN;
        if (r < 2 * I_SQ) { const int which = r / I_SQ; r %= I_SQ; const int L = r / 256, q = r % 256, nb = q & 15, kb = q >> 4;
            tr_item64(a.in[which ? 12 : 11] + (size_t)L * DM * DM, DM, DM, nb * 64, nb * 64 + 32, nullptr, (bf16_t*)(ws + (which ? WS_WPG : WS_WOUT)) + (size_t)L * DM * DM, nb * 64, kb * 64, scr, lane); continue; }
        r -= 2 * I_SQ;
        { const int L = r / 64, q = r % 64, nb = q & 15, kb = q >> 4;
            tr_item64(a.in[13] + (size_t)L * PLE * DM, DM, PLE, nb * 64, nb * 64 + 32, nullptr, (bf16_t*)(ws + WS_WPP) + (size_t)L * DM * PLE, nb * 64, kb * 64, scr, lane); }
    }
      } else {
    for (int row = gw; row < MR; row += 2 * NGW) {
        const int row1 = row + NGW; const bool has1 = row1 < MR; const int r1 = has1 ? row1 : row;
        const float* xr0 = row < NPR ? a.in[0] + (size_t)row * DM : a.in[1] + (size_t)(row - NPR) * DM;
        const float* xr1 = r1 < NPR ? a.in[0] + (size_t)r1 * DM : a.in[1] + (size_t)(r1 - NPR) * DM;
        f32x4 v0[4], v1[4];
#pragma unroll
        for (int j = 0; j < 4; ++j) { v0[j] = gld_nt<f32x4>(xr0 + 4 * lane + 256 * j); v1[j] = gld_nt<f32x4>(xr1 + 4 * lane + 256 * j); }
        float s0 = 0.f, s1 = 0.f;
        bf16_t* xb0 = (bf16_t*)(ws + WS_XB0) + (size_t)row * DM; bf16_t* xb1 = (bf16_t*)(ws + WS_XB0) + (size_t)r1 * DM;
#pragma unroll
        for (int j = 0; j < 4; ++j) { s0 += (v0[j][0] * v0[j][0] + v0[j][1] * v0[j][1]) + (v0[j][2] * v0[j][2] + v0[j][3] * v0[j][3]); s1 += (v1[j][0] * v1[j][0] + v1[j][1] * v1[j][1]) + (v1[j][2] * v1[j][2] + v1[j][3] * v1[j][3]);
            *(u32x2*)(xb0 + 4 * lane + 256 * j) = pk4(v0[j]); if (has1) *(u32x2*)(xb1 + 4 * lane + 256 * j) = pk4(v1[j]); }
        s0 = wave_sum(s0); s1 = wave_sum(s1);
        if (lane < 16) { ((float*)(ws + WS_SSP))[(size_t)row * 16 + lane] = lane == 0 ? s0 : 0.f; if (has1) ((float*)(ws + WS_SSP))[(size_t)row1 * 16 + lane] = lane == 0 ? s1 : 0.f; }
    }
    for (int i = gt; i < DEPTH * MR * 64; i += 4 * GT) {
        f32x4 v[4];
#pragma unroll
        for (int j = 0; j < 4; ++j) { const int ii = i + j * GT; const int ic = ii < DEPTH * MR * 64 ? ii : i; const int L = ic / (MR * 64), q = ic % (MR * 64), row = q >> 6, c4 = q & 63;
            const float* src = row < NPR ? a.in[5] + ((size_t)L * NPR + row) * PLE : a.in[6] + ((size_t)L * NSR + row - NPR) * PLE; v[j] = gld_nt<f32x4>(src + c4 * 4); }
#pragma unroll
        for (int j = 0; j < 4; ++j) { const int ii = i + j * GT; if (ii < DEPTH * MR * 64) *(u32x2*)((bf16_t*)(ws + WS_PB) + (size_t)ii * 4) = pk4(v[j]); }
    }
      }
    }
    for (int i = gt; i < 2052 * 32; i += GT) {
        const int pidx = i >> 5, d = i & 31; const double pos = pidx < 2048 ? (double)pidx : (double)(8192 + pidx - 2048);
        double inv = 1.0; for (int k = 0; k < d; ++k) inv *= 0.74989420933245582730;
        double rev = pos * inv * 0.15915494309189533577; rev -= __builtin_floor(rev);
        const float f = (float)rev; float* tp = (float*)(ws + WS_TAB) + (size_t)pidx * 64 + d;
        tp[0] = __builtin_amdgcn_cosf(f); tp[32] = __builtin_amdgcn_sinf(f);
    }
}
__device__ __forceinline__ void final_phase(const int w0) {
    int tid_ = TID_OF(w0); asm volatile("" : "+v"(tid_)); const int tid = tid_, lane = tid & 63, wid = tid >> 6; const int gw = blockIdx.x * 8 + wid, NGW = gridDim.x * 8;
    unsigned char* ws = ka_ws(); const float* ssp = (const float*)(ws + WS_SSP); const bf16_t* X0 = (const bf16_t*)(ws + WS_XB0); const float* gf = ka_in(14); float* outp = ka_out();
    f32x4 g[4];
#pragma unroll
    for (int j = 0; j < 4; ++j) g[j] = gld<f32x4>(gf + 4 * lane + 256 * j);
    for (int row = gw; row < MR; row += 2 * NGW) {
        const int row1 = row + NGW; const bool has1 = row1 < MR; const int r1 = has1 ? row1 : row;
        float s0 = lane < 16 ? gld<float>(ssp + (size_t)row * 16 + lane) : 0.f, s1 = lane < 16 ? gld<float>(ssp + (size_t)r1 * 16 + lane) : 0.f;
        u32x2 v0[4], v1[4];
#pragma unroll
        for (int j = 0; j < 4; ++j) { v0[j] = gld<u32x2>(X0 + (size_t)row * DM + 4 * lane + 256 * j); v1[j] = gld<u32x2>(X0 + (size_t)r1 * DM + 4 * lane + 256 * j); }
        s0 = wave_sum(s0); s1 = wave_sum(s1);
        const float rs0 = __builtin_amdgcn_rsqf(s0 * (1.f / 1024.f) + EPS), rs1 = __builtin_amdgcn_rsqf(s1 * (1.f / 1024.f) + EPS);
#pragma unroll
        for (int j = 0; j < 4; ++j) { gst_nt<f32x4>(outp + (size_t)row * DM + 4 * lane + 256 * j, bf4(v0[j]) * rs0 * g[j]); if (has1) gst_nt<f32x4>(outp + (size_t)row1 * DM + 4 * lane + 256 * j, bf4(v1[j]) * rs1 * g[j]); }
    }
}

#define RLX_AGENT __ATOMIC_RELAXED, __HIP_MEMORY_SCOPE_AGENT
#define XB_TMO      128
#define XB_XCNT(j)  (256  + 64 * (j))
#define XB_XSUB(j)  (1280 + 64 * (j))
#define XB_XGEN(j)  (2304 + 64 * (j))
#define XB_TOP      3328
#define XB_TOPGEN   3392
#define XCD_BAR_WORDS 3456
#define XB_SPIN_CAP (1u << 18)

__device__ __forceinline__ unsigned xb_ld(unsigned* p)              { return __hip_atomic_load((GAS unsigned*)p, __ATOMIC_RELAXED, __HIP_MEMORY_SCOPE_AGENT); }
__device__ __forceinline__ unsigned xb_add(unsigned* p, unsigned v) { return __hip_atomic_fetch_add((GAS unsigned*)p, v, __ATOMIC_RELAXED, __HIP_MEMORY_SCOPE_AGENT); }
__device__ __forceinline__ unsigned xb_xcc_id() { return (unsigned)__builtin_amdgcn_s_getreg((3 << 11) | 20) & 0xFu; }
#define XB_SPIN(cond, bar) do { unsigned _sp = 0; while (cond) { __builtin_amdgcn_s_sleep(1); \
    if ((++_sp & 255u) == 0u) { if (xb_ld(&(bar)[XB_TMO])) break; if (_sp > XB_SPIN_CAP) { atomicAdd(&(bar)[XB_TMO], 1u); break; } } } } while (0)

struct XcdBarrier {
    unsigned* bar; unsigned x; int w0;
    volatile LAS unsigned* st;
};

__device__ __forceinline__ XcdBarrier xcd_barrier_post(unsigned* bar, volatile LAS unsigned* st, int w0) {
    XcdBarrier b; b.bar = bar; b.x = xb_xcc_id(); b.st = st; b.w0 = w0;
    if (TID_OF(w0) == 0) (void)xb_add(&bar[XB_XCNT(b.x)], 1u);
    return b;
}
__device__ __forceinline__ void xcd_barrier_complete(unsigned* bar, unsigned x, unsigned& nloc, unsigned& nx) {
    const unsigned G = gridDim.x * gridDim.y * gridDim.z;
    unsigned sum, cnt, mine, sp = 0u;
    for (;;) {
        sum = 0u; cnt = 0u; mine = 0u;
#pragma unroll
        for (unsigned j = 0; j < 16; ++j) { const unsigned c = xb_ld(&bar[XB_XCNT(j)]); sum += c; cnt += (c > 0u) ? 1u : 0u; mine = (j == x) ? c : mine; }
        if (sum == G) break;
        __builtin_amdgcn_s_sleep(1);
        if ((++sp & 255u) == 0u) { if (xb_ld(&bar[XB_TMO])) break; if (sp > XB_SPIN_CAP) { atomicAdd(&bar[XB_TMO], 1u); break; } }
    }
    nloc = mine > 0u ? mine : 1u; nx = cnt > 0u ? cnt : 1u;
}

__device__ __forceinline__ void xcd_barrier(const XcdBarrier& b) {
    asm volatile("s_waitcnt vmcnt(0)" ::: "memory");
    __syncthreads();
    if (TID_OF(b.w0) == 0) {
        unsigned* bar = b.bar; unsigned bx = b.x; asm volatile("" : "+s"(bar), "+s"(bx));
        __builtin_amdgcn_s_waitcnt(0);
        unsigned nloc = b.st[0], nx = b.st[1];
        if (nloc == 0u) { xcd_barrier_complete(bar, bx, nloc, nx); b.st[0] = nloc; b.st[1] = nx; }
        const unsigned old = xb_add(&bar[XB_XSUB(bx)], 1u);
        const unsigned gen = old / nloc;
        if (old + 1u == (gen + 1u) * nloc) {
            __builtin_amdgcn_fence(__ATOMIC_RELEASE, "agent");
            asm volatile("s_waitcnt vmcnt(0)" ::: "memory");
            const unsigned og = xb_add(&bar[XB_TOP], 1u);
            const unsigned tg = og / nx;
            if (og + 1u == (tg + 1u) * nx) xb_add(&bar[XB_TOPGEN], 1u);
            else XB_SPIN(xb_ld(&bar[XB_TOPGEN]) == tg, bar);
            __builtin_amdgcn_fence(__ATOMIC_ACQUIRE, "agent");
            xb_add(&bar[XB_XGEN(bx)], 1u);
            asm volatile("s_waitcnt vmcnt(0)" ::: "memory");
        } else {
            XB_SPIN(xb_ld(&bar[XB_XGEN(bx)]) == gen, bar);
            __builtin_amdgcn_fence(__ATOMIC_ACQUIRE, "agent");
            asm volatile("s_waitcnt vmcnt(0)" ::: "memory");
        }
    }
    __syncthreads();
}

#ifndef MK_SPLIT
#define MK_SPLIT 0
#endif
__device__ __forceinline__ unsigned char* opq(unsigned char* p) { asm volatile("" : "+s"(p)); return p; }
__global__ void __launch_bounds__(512, 2) fwd(Args a) {
    extern __shared__ __attribute__((aligned(16))) unsigned char lds_raw[];
    LAS unsigned char* lds = (LAS unsigned char*)lds_raw;
    cg::grid_group grid = cg::this_grid();
    volatile LAS unsigned* misc = (volatile LAS unsigned*)(lds + 139264);
    if (a.ph_hi == 0x7fffffff) grid.sync();
    const int w0 = __builtin_amdgcn_readfirstlane((int)threadIdx.x >> 6);
    if (TID_OF(w0) < 16) misc[TID_OF(w0)] = 0u;
    __syncthreads();
    const XcdBarrier bar = xcd_barrier_post((unsigned*)(a.ws + WS_BAR), misc, w0);
    const int G = gridDim.x, c = blockIdx.x;
#if MK_SPLIT
    const int lo = a.ph_lo, hi = a.ph_hi;
#define IN(k) (lo <= (k) && (k) < hi)
#define SEAM(k) do { if (IN(k) && IN((k) + 1)) grid.sync(); } while (0)
#else
#define IN(k) true
#define SEAM(k) xcd_barrier(bar)
#endif
#ifndef DIS_P0
    if (IN(0)) p0_phase(lds, a, w0);
#endif
    SEAM(0);
#pragma unroll 1
    for (int L = 0; L < DEPTH; ++L) {
        const int ph = 1 + 4 * L;
        if (IN(ph)) {
            int cp_ = c; asm volatile("" : "+s"(cp_)); const bool pp_first = ((cp_ >> 3) & 1) != 0;
#pragma unroll 1
            for (int step = 0; step < 2; ++step) {
                if ((step == 0) != pp_first) {
                    unsigned char* ws = ka_ws();
                    pg8::Gemm g{(const bf16_t*)(ws + WS_XB0), (const bf16_t*)(ws + WS_WIN) + (size_t)L * INW * DM, MR, INW, DM}; int c1_ = c; asm volatile("" : "+s"(c1_)); pg8::StaticOrder S; S.init(MR, INW, G, c1_);
                    EpiIn E{L};
                    pg8::gemm_phase<EpiIn, pg8::StaticOrder, true, true>(lds, g, S, E, w0);
                } else {
                    unsigned char* ws = ka_ws();
                    pg8::Gemm g{(const bf16_t*)(ws + WS_PB) + (size_t)L * MR * PLE, (const bf16_t*)(ws + WS_WPP) + (size_t)L * DM * PLE, MR, DM, PLE};
                    const int nu = (MR / 256) * (INW / 256); int c2_ = c; asm volatile("" : "+s"(c2_)); FillOrder S; S.init(MR, DM, G, c2_, nu % G);
                    EpiPP E{0};
                    pg8::gemm_phase<EpiPP, FillOrder, true, true>(lds, g, S, E, w0);
                }
            }
        }
        SEAM(ph);
        if (IN(ph + 1)) {
#ifndef DIS_P2
            unsigned char* ws = ka_ws();
            p2_phase(lds, L, w0);
#endif
        }
        SEAM(ph + 1);
        if (IN(ph + 2)) {
#ifndef DIS_P3A
            unsigned char* ws = ka_ws();
            pg8::Gemm g{(const bf16_t*)(ws + WS_MIX), (const bf16_t*)(ws + WS_WOUT) + (size_t)L * DM * DM, NPR, DM, DM}; pg8::StaticOrder S; S.init(NPR, DM, G, c);
            EpiOut E{0};
            int cb_ = c; asm volatile("" : "+s"(cb_)); const bool small_first = ((cb_ >> 3) & 3) == 0;
#pragma unroll 1
            for (int step = 0; step < 2; ++step) {
                if ((step == 0) == small_first) small_gemm<EpiOut>(lds, g.A + (size_t)NPR * DM, g.Bt, E, w0);
                else pg8::gemm_phase<EpiOut, pg8::StaticOrder, true, true>(lds, g, S, E, w0);
            }
#endif
        }
        SEAM(ph + 2);
        if (IN(ph + 3)) {
#ifndef DIS_P3B
            unsigned char* ws = ka_ws();
            pg8::Gemm g{(const bf16_t*)(ws + WS_XB1), (const bf16_t*)(ws + WS_WPG) + (size_t)L * DM * DM, NPR, DM, DM}; pg8::StaticOrder S; S.init(NPR, DM, G, c);
            EpiGate E{0};
            int cb_ = c; asm volatile("" : "+s"(cb_)); const bool small_first = ((cb_ >> 3) & 3) == 0;
#pragma unroll 1
            for (int step = 0; step < 2; ++step) {
                if ((step == 0) == small_first) small_gemm<EpiGate>(lds, g.A + (size_t)NPR * DM, g.Bt, E, w0);
                else pg8::gemm_phase<EpiGate, pg8::StaticOrder, true, true>(lds, g, S, E, w0);
            }
#endif
        }
        SEAM(ph + 3);
    }
    if (IN(17)) final_phase(w0);
#undef IN
#undef SEAM
}

extern "C" void kernel_launch(void* const* d_in, const int* in_sizes, int n_in, void* d_out, int out_size, void* d_ws, size_t ws_size, hipStream_t stream) {
    static int grid = 0;
    if (grid == 0) {
        if (n_in != 15 || (size_t)out_size != O_END || ws_size < WS_END) { fprintf(stderr, "kernel_launch: unexpected shapes (n_in %d out %d ws %zu)\n", n_in, out_size, ws_size); grid = -1; return; }
        int dev = 0, cus = 0, per = 0;
        if (hipGetDevice(&dev) != hipSuccess || hipDeviceGetAttribute(&cus, hipDeviceAttributeMultiprocessorCount, dev) != hipSuccess) { grid = -1; return; }
        if (hipFuncSetAttribute((const void*)fwd, hipFuncAttributeMaxDynamicSharedMemorySize, LDS_BYTES) != hipSuccess) { fprintf(stderr, "kernel_launch: hipFuncSetAttribute failed\n"); grid = -1; return; }
        if (hipOccupancyMaxActiveBlocksPerMultiprocessor(&per, (const void*)fwd, 512, LDS_BYTES) != hipSuccess || per < 1) { fprintf(stderr, "kernel_launch: occupancy query %d\n", per); per = 1; }
        (void)hipGetLastError();
        grid = cus;
        fprintf(stderr, "kernel_launch: grid %d (cus %d x per_cu %d), ws %zu\n", grid, cus, per, ws_size);
    }
    if (grid < 0) return;
    if (hipMemsetAsync((char*)d_ws + WS_BAR, 0, 16384, stream) != hipSuccess) { fprintf(stderr, "kernel_launch: memset failed\n"); return; }
    Args a{};
    for (int i = 0; i < 15; ++i) a.in[i] = (const float*)d_in[i];
    a.out = (float*)d_out; a.ws = (unsigned char*)d_ws;
#if MK_SPLIT
    for (int ph = 0; ph < 18; ++ph) { a.ph_lo = ph; a.ph_hi = ph + 1; hipLaunchKernelGGL(fwd, dim3(grid), dim3(512), LDS_BYTES, stream, a); }
#else
    a.ph_lo = 0; a.ph_hi = 18;
    void* args[] = {&a};
    const hipError_t e = hipLaunchCooperativeKernel((const void*)fwd, dim3(grid), dim3(512), args, LDS_BYTES, stream);
    if (e != hipSuccess) fprintf(stderr, "kernel_launch: cooperative launch failed: %s (grid %d)\n", hipGetErrorString(e), grid);
#endif
}
```
